# Optimizing an MI355X kernel written in HIP

```python
import jax, jax.numpy as jnp
from jax import lax
import numpy as np

D_MODEL = 1024
BATCH = 8
SEQ = 4096
DEPTH = 4

CHUNK = 64
POOL_WINDOWS = (2, 4, 8, 16)
POOL_GROUPS = len(POOL_WINDOWS)
D_POOL = D_MODEL // 2
POOL_GC = D_POOL // POOL_GROUPS
RWKV_HEAD = 64
D_RWKV = D_MODEL
RWKV_HEADS = D_RWKV // RWKV_HEAD
D_DECAY_LORA = 64
D_AAA_LORA = 64
D_GATE_LORA = 160
D_FF = 4 * D_MODEL
N_BRANCH = 2
D_SHIFTED = 3 * D_RWKV + D_DECAY_LORA + D_AAA_LORA + D_GATE_LORA
D_IN = D_POOL + D_SHIFTED + N_BRANCH * D_MODEL
SHIFT_SPLITS = (D_RWKV, 2 * D_RWKV, 3 * D_RWKV, 3 * D_RWKV + D_DECAY_LORA,
                3 * D_RWKV + D_DECAY_LORA + D_AAA_LORA)
ALPHA = (2 * DEPTH) ** 0.25
BETA = (8 * DEPTH) ** -0.25
LN_EPS = 1e-5
GN_EPS = 64e-5

kernel_name = "hybrid_pool_rwkv7_adaln_deepnorm"


def layer_norm(x, g, b, eps):
    xf = x.astype(jnp.float32)
    mu = jnp.mean(xf, axis=-1, keepdims=True)
    var = jnp.mean(jnp.square(xf - mu), axis=-1, keepdims=True)
    return (xf - mu) * lax.rsqrt(var + eps) * g.astype(jnp.float32) + b.astype(jnp.float32)


def token_shift(p):
    return jnp.pad(p, ((0, 0), (1, 0), (0, 0)))[:, :-1]


def multiscale_pool(u):
    b, s, _ = u.shape
    ug = u.astype(jnp.float32).reshape(b, s, POOL_GROUPS, POOL_GC)
    cs = jnp.cumsum(ug, axis=1)
    count = jnp.arange(1, s + 1, dtype=jnp.float32)
    outs = []
    for gi, w in enumerate(POOL_WINDOWS):
        cg = cs[:, :, gi]
        lag = jnp.pad(cg[:, : s - w], ((0, 0), (w, 0), (0, 0)))
        cnt = jnp.minimum(count, float(w))
        outs.append((cg - lag) / cnt[None, :, None] - ug[:, :, gi])
    return jnp.stack(outs, axis=2)


def pool_branch(u, pool_mix, pool_scale, w_up):
    b, s, _ = u.shape
    m = multiscale_pool(u)
    m = jnp.einsum('bsgc,gcd->bsgd', m, pool_mix.astype(jnp.float32)).reshape(b, s, D_POOL)
    m = (m * pool_scale.astype(jnp.float32)).astype(u.dtype)
    return m @ w_up


def wkv7_scan(r, decay, k, v, kk, a):
    b, s, h, n = r.shape

    def to_chunks(z):
        return jnp.moveaxis(z, 1, 0).reshape(s // CHUNK, CHUNK, b, h, n)

    seqs = tuple(to_chunks(z) for z in (r, decay, k, v, -kk, kk * a))

    def step(state, inp):
        r_t, w_t, k_t, v_t, a_t, b_t = inp
        sa = jnp.einsum('bhvk,bhk->bhv', state, a_t)
        state = (state * w_t[:, :, None, :] + sa[..., None] * b_t[:, :, None, :]
                 + v_t[..., None] * k_t[:, :, None, :])
        return state, jnp.einsum('bhvk,bhk->bhv', state, r_t)

    def chunk_step(state, chunk_inp):
        return lax.scan(step, state, chunk_inp)

    state0 = jnp.zeros((b, h, n, n), jnp.float32)
    _, out = lax.scan(chunk_step, state0, seqs)
    return jnp.moveaxis(out.reshape(s, b, h, n), 0, 1)


def rwkv7_branch(ps, mu, w0, w_decay_up, a0, w_aaa_up, w_gate_up, k_k, k_a, r_k, gn_g, gn_b, w_up):
    b, s, _ = ps.shape
    xs = ps + (token_shift(ps) - ps) * mu
    r, k, v, xw, xa, xg = jnp.split(xs, SHIFT_SPLITS, axis=-1)
    w = -jax.nn.softplus(-(w0 + jnp.tanh(xw) @ w_decay_up)) - 0.5
    decay = jnp.exp(-jnp.exp(w.astype(jnp.float32)))
    a = jax.nn.sigmoid(a0 + xa @ w_aaa_up)
    g = jax.nn.sigmoid(xg) @ w_gate_up

    def heads(z):
        return z.astype(jnp.float32).reshape(b, s, RWKV_HEADS, RWKV_HEAD)

    kk = heads(k * k_k)
    kk = kk / jnp.maximum(jnp.linalg.norm(kk, axis=-1, keepdims=True), 1e-12)
    k = k * (1 + (a - 1) * k_a)
    rh, kh, vh = heads(r), heads(k), heads(v)
    o = wkv7_scan(rh, heads(decay), kh, vh, kk, heads(a))
    o = layer_norm(o, gn_g.reshape(RWKV_HEADS, RWKV_HEAD), gn_b.reshape(RWKV_HEADS, RWKV_HEAD), GN_EPS)
    o = o + jnp.sum(rh * kh * r_k.astype(jnp.float32), axis=-1, keepdims=True) * vh
    o = (o.reshape(b, s, D_RWKV) * g.astype(jnp.float32)).astype(ps.dtype)
    return o @ w_up


def setup_inputs(seed: int = 0) -> dict:
    key = jax.random.key(seed)
    ks = jax.random.split(key, 28)
    L = DEPTH

    def nrm(k, shape, scale):
        return jax.random.normal(k, shape, jnp.float32) * scale

    return {
        "x": nrm(ks[0], (BATCH, SEQ, D_MODEL), 1.0),
        "c": nrm(ks[1], (BATCH, D_MODEL), 1.0),
        "w_ada": nrm(ks[2], (L, D_MODEL, 6 * D_MODEL), 0.5 * D_MODEL ** -0.5),
        "b_ada": nrm(ks[3], (L, 6 * D_MODEL), 0.02),
        "w_in": nrm(ks[4], (L, D_MODEL, D_IN), D_MODEL ** -0.5),
        "mu_shift": jax.random.uniform(ks[5], (L, D_SHIFTED), jnp.float32),
        "pool_mix": nrm(ks[6], (L, POOL_GROUPS, POOL_GC, POOL_GC), POOL_GC ** -0.5),
        "pool_scale": 1.0 + nrm(ks[7], (L, D_POOL), 0.1),
        "w_pool_up": nrm(ks[8], (L, D_POOL, D_MODEL), D_POOL ** -0.5),
        "w0": jax.random.uniform(ks[9], (L, D_RWKV), jnp.float32, -4.0, 1.0),
        "w_decay_up": nrm(ks[10], (L, D_DECAY_LORA, D_RWKV), 0.5 * D_DECAY_LORA ** -0.5),
        "a0": nrm(ks[11], (L, D_RWKV), 0.5),
        "w_aaa_up": nrm(ks[12], (L, D_AAA_LORA, D_RWKV), 0.5 * D_AAA_LORA ** -0.5),
        "w_gate_up": nrm(ks[13], (L, D_GATE_LORA, D_RWKV), D_GATE_LORA ** -0.5),
        "k_k": 0.85 + nrm(ks[14], (L, D_RWKV), 0.05),
        "k_a": 1.0 + nrm(ks[15], (L, D_RWKV), 0.05),
        "r_k": nrm(ks[16], (L, RWKV_HEADS, RWKV_HEAD), 0.1),
        "gn_g": 1.0 + nrm(ks[17], (L, D_RWKV), 0.05),
        "gn_b": nrm(ks[18], (L, D_RWKV), 0.02),
        "w_rwkv_up": nrm(ks[19], (L, D_RWKV, D_MODEL), D_RWKV ** -0.5),
        "w_out": nrm(ks[20], (L, D_MODEL, D_MODEL), BETA * D_MODEL ** -0.5),
        "ln1_g": 1.0 + nrm(ks[21], (L, D_MODEL), 0.05),
        "ln1_b": nrm(ks[22], (L, D_MODEL), 0.02),
        "w_ff1": nrm(ks[23], (L, D_MODEL, D_FF), D_MODEL ** -0.5),
        "w_ff2": nrm(ks[24], (L, D_FF, D_MODEL), BETA * D_FF ** -0.5),
        "ln2_g": 1.0 + nrm(ks[25], (L, D_MODEL), 0.05),
        "ln2_b": nrm(ks[26], (L, D_MODEL), 0.02),
    }


def reference(x, c, w_ada, b_ada, w_in, mu_shift, pool_mix, pool_scale, w_pool_up, w0, w_decay_up,
              a0, w_aaa_up, w_gate_up, k_k, k_a, r_k, gn_g, gn_b, w_rwkv_up, w_out, ln1_g, ln1_b,
              w_ff1, w_ff2, ln2_g, ln2_b):
    cond = jax.nn.silu(c)
    for l in range(DEPTH):
        mod = (cond @ w_ada[l] + b_ada[l])[:, None, :]
        sh1, sc1, gt1, sh2, sc2, gt2 = jnp.split(mod, 6, axis=-1)
        h = x * (1 + sc1) + sh1
        p = h @ w_in[l]
        p_pool, p_rwkv, p_gate = jnp.split(p, (D_POOL, D_POOL + D_SHIFTED), axis=-1)
        y_pool = pool_branch(p_pool, pool_mix[l], pool_scale[l], w_pool_up[l])
        y_rwkv = rwkv7_branch(p_rwkv, mu_shift[l], w0[l], w_decay_up[l], a0[l], w_aaa_up[l],
                              w_gate_up[l], k_k[l], k_a[l], r_k[l], gn_g[l], gn_b[l], w_rwkv_up[l])
        g_pool, g_rwkv = jnp.split(jax.nn.sigmoid(p_gate), 2, axis=-1)
        mixed = (g_pool * y_pool + g_rwkv * y_rwkv) @ w_out[l]
        x = layer_norm(ALPHA * x + (1 + gt1) * mixed, ln1_g[l], ln1_b[l], LN_EPS).astype(x.dtype)
        h = x * (1 + sc2) + sh2
        f = jnp.square(jax.nn.relu(h @ w_ff1[l])) @ w_ff2[l]
        x = layer_norm(ALPHA * x + (1 + gt2) * f, ln2_g[l], ln2_b[l], LN_EPS).astype(x.dtype)
    return x
```

```cpp
#include <hip/hip_runtime.h>
#include <hip/hip_cooperative_groups.h>
#include <cstdio>
namespace cg = cooperative_groups;

#define DBG_OFF OFF_TMP
#ifndef SINGLE_LAUNCH
#define SINGLE_LAUNCH 1
#endif

typedef unsigned short bf16_t;
typedef short bf16x8 __attribute__((ext_vector_type(8)));
typedef float f32x4 __attribute__((ext_vector_type(4)));
typedef unsigned u32x4 __attribute__((ext_vector_type(4)));
typedef unsigned u32x2 __attribute__((ext_vector_type(2)));

#define DEVFN __device__ __forceinline__

constexpr int DM = 1024, NB = 8, SEQ = 4096, DEPTH = 4, MTOK = NB * SEQ;
constexpr int D_IN = 5920, D_SH = 3360, NP1 = 4096;
constexpr int DFF = 4096;
constexpr float ALPHA = 1.681792830507429f;
constexpr float LN_EPS = 1e-5f, GN_EPS = 64e-5f;
constexpr int NTHR = 512;

constexpr size_t MiB = 1024 * 1024;
constexpr size_t OFF_W1T = 0, OFF_WGT = 8 * MiB, OFF_WPUT = 12 * MiB, OFF_WGUT = 13 * MiB, OFF_WDT = 13 * MiB + 512 * 1024,
                 OFF_WAT = 13 * MiB + 640 * 1024, OFF_WRUT = 14 * MiB, OFF_WOUTT = 16 * MiB, OFF_WFF1T = 18 * MiB, OFF_WFF2T = 26 * MiB,
                 OFF_MOD = 34 * MiB, OFF_MODP = 35 * MiB, OFF_BONUS = 41 * MiB, OFF_BAR = 43 * MiB, OFF_P = 44 * MiB,
                 OFF_H = 300 * MiB, OFF_O = 364 * MiB, OFF_MB = 428 * MiB, OFF_GA = 460 * MiB;
constexpr size_t OFF_MIX = OFF_P, OFF_TMP = OFF_P + 64 * MiB, OFF_HID = OFF_P;

struct Params {
    const float *x, *c, *w_ada, *b_ada, *w_in, *mu_shift, *pool_mix, *pool_scale, *w_pool_up, *w0, *w_decay_up, *a0, *w_aaa_up,
        *w_gate_up, *k_k, *k_a, *r_k, *gn_g, *gn_b, *w_rwkv_up, *w_out, *ln1_g, *ln1_b, *w_ff1, *w_ff2, *ln2_g, *ln2_b;
    float* out;
    unsigned char* ws;
};

typedef const __attribute__((address_space(4))) Params* KP;
extern __shared__ __attribute__((aligned(16))) unsigned char dyn_lds[];
constexpr int LDS_BYTES = 155136;

DEVFN int opaque_tid() { int t; asm volatile("v_mov_b32 %0, %1" : "=v"(t) : "v"(threadIdx.x)); return t; }
DEVFN int opaque_bid() { int t; asm volatile("s_mov_b32 %0, %1" : "=s"(t) : "s"(blockIdx.x)); return t; }
#define TIDX opaque_tid()
#define BIDX opaque_bid()
typedef float f32x2 __attribute__((ext_vector_type(2)));
typedef __bf16 bf16x2_t __attribute__((ext_vector_type(2)));
DEVFN unsigned pk2bf(float lo, float hi) { const f32x2 v = {lo, hi}; const bf16x2_t b = __builtin_convertvector(v, bf16x2_t); return __builtin_bit_cast(unsigned, b); }
DEVFN float bflo(unsigned u) { return __uint_as_float(u << 16); }
DEVFN float bfhi(unsigned u) { return __uint_as_float(u & 0xffff0000u); }
DEVFN void unpack8(const u32x4 u, float* f) {
    f[0] = bflo(u.x); f[1] = bfhi(u.x); f[2] = bflo(u.y); f[3] = bfhi(u.y); f[4] = bflo(u.z); f[5] = bfhi(u.z); f[6] = bflo(u.w); f[7] = bfhi(u.w);
}
DEVFN float sigmoidf_(float x) { return __builtin_amdgcn_rcpf(1.0f + __expf(-x)); }
template <int CTRL> DEVFN float dpp_f(float v) { return __int_as_float(__builtin_amdgcn_update_dpp(0, __float_as_int(v), CTRL, 0xF, 0xF, true)); }
DEVFN float row16_sum(float v) {
    v += dpp_f<0xB1>(v); v += dpp_f<0x4E>(v); v += dpp_f<0x141>(v); v += dpp_f<0x140>(v); return v;
}
DEVFN float oct_sum(float v) {
    v += dpp_f<0xB1>(v); v += dpp_f<0x4E>(v); v += dpp_f<0x141>(v); return v;
}
DEVFN float wave_sum(float v) {
    v = row16_sum(v);
    const int vi = __float_as_int(v);
    return (__int_as_float(__builtin_amdgcn_readlane(vi, 0)) + __int_as_float(__builtin_amdgcn_readlane(vi, 16))) +
           (__int_as_float(__builtin_amdgcn_readlane(vi, 32)) + __int_as_float(__builtin_amdgcn_readlane(vi, 48)));
}

constexpr int BM = 256, BK = 64, HALF = 128, HT = HALF * BK;
DEVFN int lds_byte(int r, int c) { int st = (r >> 4) * 2 + (c >> 5), rr = r & 15, cc = c & 31, ob = rr * 64 + cc * 2; return st * 1024 + (ob ^ (((ob >> 9) & 1) << 5)); }
DEVFN void stage_rc(int b, int& R, int& C) { int st = b / 1024, sb = b % 1024, swz = sb ^ (((sb >> 9) & 1) << 5); R = (st >> 1) * 16 + swz / 64; C = (st & 1) * 32 + (swz % 64) / 2; }

struct EpiArgs { bf16_t* o16; const bf16_t* o16b; const float* xsrc; float* y; const float* gate; int ld; };

template <int MODE> DEVFN void epi_apply(const EpiArgs& e, int row, int col, f32x4 v) {
    if (MODE == 0) {
        u32x2 w; w.x = pk2bf(v[0], v[1]); w.y = pk2bf(v[2], v[3]);
        *(u32x2*)(e.o16 + (size_t)row * e.ld + col) = w;
    } else if (MODE == 1 || MODE == 3) {
        u32x2* p = (u32x2*)(e.o16 + (size_t)row * e.ld + col); u32x2 o = *p;
        u32x2 w; w.x = pk2bf(bflo(o.x) * v[0], bfhi(o.x) * v[1]); w.y = pk2bf(bflo(o.y) * v[2], bfhi(o.y) * v[3]); *p = w;
    } else if (MODE == 2) {
        u32x2 w; w.x = pk2bf(sigmoidf_(v[0]), sigmoidf_(v[1])); w.y = pk2bf(sigmoidf_(v[2]), sigmoidf_(v[3]));
        *(u32x2*)(e.o16 + (size_t)row * e.ld + col) = w;
    } else if (MODE == 4) {
        u32x2* p = (u32x2*)(e.o16 + (size_t)row * e.ld + col); u32x2 o = *p; const u32x2 t = *(const u32x2*)(e.o16b + (size_t)row * e.ld + col);
        u32x2 w; w.x = pk2bf(bflo(o.x) + bflo(t.x) * v[0], bfhi(o.x) + bfhi(t.x) * v[1]); w.y = pk2bf(bflo(o.y) + bflo(t.y) * v[2], bfhi(o.y) + bfhi(t.y) * v[3]); *p = w;
    } else if (MODE == 5) {
        const f32x4 xv = *(const f32x4*)(e.xsrc + (size_t)row * DM + col);
        const f32x4 g = *(const f32x4*)(e.gate + (size_t)(row >> 12) * (6 * DM) + col);
        f32x4 o; for (int j = 0; j < 4; ++j) o[j] = ALPHA * xv[j] + (1.0f + g[j]) * v[j];
        *(f32x4*)(e.y + (size_t)row * DM + col) = o;
    } else if (MODE == 6) {
        float r0 = fmaxf(v[0], 0.f), r1 = fmaxf(v[1], 0.f), r2 = fmaxf(v[2], 0.f), r3 = fmaxf(v[3], 0.f);
        u32x2 w; w.x = pk2bf(r0 * r0, r1 * r1); w.y = pk2bf(r2 * r2, r3 * r3);
        *(u32x2*)(e.o16 + (size_t)row * e.ld + col) = w;
    }
}

#define LAS __attribute__((address_space(3)))
template <int MODE>
DEVFN void gemm_tile(const bf16_t* __restrict__ A, const int lda, const bf16_t* __restrict__ Bt, const int ldb, const int K,
                     const int brow, const int bcol, const EpiArgs& e) {
    LAS unsigned char* lds = (LAS unsigned char*)dyn_lds;
    constexpr int HTB = HT * 2;
    const int tid = TIDX, wid = __builtin_amdgcn_readfirstlane(tid >> 6), lane = tid & 63, wr = wid >> 2, wc = wid & 3, fr = lane & 15, fq = lane >> 4;
    unsigned voffA[2], voffB[2];
#pragma unroll
    for (int i = 0; i < 2; ++i) { int R, C; stage_rc(tid * 16 + i * 8192, R, C); voffA[i] = (unsigned)(R * lda + C) * 2u; voffB[i] = (unsigned)(R * ldb + C) * 2u; }
    const size_t kstep = (size_t)(BK * 2), hstepA = (size_t)HALF * lda * 2, hstepB = (size_t)HALF * ldb * 2;
    const unsigned ldsw = (unsigned)wid * 1024u;
    const int aoff = lds_byte(wr * 64 + fr, fq * 8), boff = lds_byte(wc * 32 + fr, fq * 8);
#define SA(b, h) (((b) * 2 + (h)) * HTB)
#define SB(b, h) ((4 + (b) * 2 + (h)) * HTB)
#define STAGE(bufoff, gbase, voff) do { _Pragma("unroll") for (int _i = 0; _i < 2; ++_i) \
    __builtin_amdgcn_global_load_lds((const unsigned*)((const char*)(gbase) + (voff)[_i]), (LAS unsigned*)(lds + (bufoff) + ldsw + _i * 8192), 16, 0, 0); } while (0)
#define LDA(dst, b, h) do { _Pragma("unroll") for (int m = 0; m < 4; ++m) _Pragma("unroll") for (int k = 0; k < 2; ++k) dst[m][k] = *(const LAS bf16x8*)(lds + SA(b, h) + aoff + m * 2048 + k * 1024); } while (0)
#define LDB(dst, b, h) do { _Pragma("unroll") for (int n = 0; n < 2; ++n) _Pragma("unroll") for (int k = 0; k < 2; ++k) dst[n][k] = *(const LAS bf16x8*)(lds + SB(b, h) + boff + n * 2048 + k * 1024); } while (0)
#define MMA(ai, bj, At_, Bt_) do { __builtin_amdgcn_s_setprio(1); \
    _Pragma("unroll") for (int m = 0; m < 4; ++m) _Pragma("unroll") for (int n = 0; n < 2; ++n) _Pragma("unroll") for (int k = 0; k < 2; ++k) \
      acc[ai][bj][m][n] = __builtin_amdgcn_mfma_f32_16x16x32_bf16(Bt_[n][k], At_[m][k], acc[ai][bj][m][n], 0, 0, 0); \
    __builtin_amdgcn_s_setprio(0); } while (0)
#define WAIT_V(n) asm volatile("s_waitcnt vmcnt(" #n ")" ::: "memory")
#define WAIT_L(n) asm volatile("s_waitcnt lgkmcnt(" #n ")" ::: "memory")
#define BAR __builtin_amdgcn_s_barrier()
#define SCHED __builtin_amdgcn_sched_barrier(0)
    f32x4 acc[2][2][4][2];
#pragma unroll
    for (int a = 0; a < 2; ++a)
#pragma unroll
        for (int b = 0; b < 2; ++b)
#pragma unroll
            for (int m = 0; m < 4; ++m)
#pragma unroll
                for (int n = 0; n < 2; ++n) acc[a][b][m][n] = (f32x4){0.f, 0.f, 0.f, 0.f};
    bf16x8 At[4][2], B0[2][2], B1[2][2];
    const int nt = K / BK;
    const char* cA = (const char*)A + (size_t)brow * lda * 2; const char* cB = (const char*)Bt + (size_t)bcol * ldb * 2;
    asm volatile("s_waitcnt vmcnt(0) lgkmcnt(0)" ::: "memory");
    __syncthreads();
    STAGE(SB(0, 0), cB, voffB); STAGE(SA(0, 0), cA, voffA);
    STAGE(SB(0, 1), cB + hstepB, voffB); STAGE(SA(0, 1), cA + hstepA, voffA);
    if (wr == 1) BAR;
    WAIT_V(4); BAR;
    STAGE(SB(1, 0), cB + kstep, voffB); STAGE(SA(1, 0), cA + kstep, voffA); STAGE(SB(1, 1), cB + hstepB + kstep, voffB);
    WAIT_V(6); BAR;
    for (int t = 0; t < nt - 2; t += 2) {
        const char* a1 = cA + (size_t)(t + 1) * kstep; const char* a2 = a1 + kstep; const char* a3 = a2 + kstep;
        const char* b2 = cB + (size_t)(t + 2) * kstep; const char* b3 = b2 + kstep;
        LDB(B0, 0, 0); SCHED; LDA(At, 0, 0); STAGE(SA(1, 1), a1 + hstepA, voffA);
        WAIT_L(8); BAR; WAIT_L(0); MMA(0, 0, At, B0); BAR; SCHED;
        LDB(B1, 0, 1); STAGE(SB(0, 0), b2, voffB);
        BAR; WAIT_L(0); MMA(0, 1, At, B1); BAR;
        LDA(At, 0, 1); STAGE(SA(0, 0), a2, voffA);
        BAR; WAIT_L(0); MMA(1, 0, At, B0); BAR; SCHED;
        STAGE(SB(0, 1), b2 + hstepB, voffB);
        WAIT_V(6); BAR; MMA(1, 1, At, B1); BAR;
        LDB(B0, 1, 0); SCHED; LDA(At, 1, 0); STAGE(SA(0, 1), a2 + hstepA, voffA);
        WAIT_L(8); BAR; WAIT_L(0); MMA(0, 0, At, B0); BAR; SCHED;
        LDB(B1, 1, 1); STAGE(SB(1, 0), b3, voffB);
        BAR; WAIT_L(0); MMA(0, 1, At, B1); BAR;
        LDA(At, 1, 1); STAGE(SA(1, 0), a3, voffA);
        BAR; WAIT_L(0); MMA(1, 0, At, B0); BAR; SCHED;
        STAGE(SB(1, 1), b3 + hstepB, voffB);
        WAIT_V(6); BAR; MMA(1, 1, At, B1); BAR;
    }
    { LDB(B0, 0, 0); LDA(At, 0, 0); STAGE(SA(1, 1), cA + (size_t)(nt - 1) * kstep + hstepA, voffA);
      BAR; WAIT_L(0); MMA(0, 0, At, B0); BAR;
      LDB(B1, 0, 1); BAR; WAIT_L(0); MMA(0, 1, At, B1); BAR;
      LDA(At, 0, 1); WAIT_V(4); BAR; WAIT_L(0); MMA(1, 0, At, B0); MMA(1, 1, At, B1); BAR; }
    { LDB(B0, 1, 0); LDA(At, 1, 0); WAIT_V(2); BAR; WAIT_L(0); MMA(0, 0, At, B0); BAR;
      LDB(B1, 1, 1); WAIT_V(0); BAR; WAIT_L(0); MMA(0, 1, At, B1); BAR;
      LDA(At, 1, 1); BAR; WAIT_L(0); MMA(1, 0, At, B0); MMA(1, 1, At, B1); BAR; }
    if (wr == 0) BAR;
#pragma unroll
    for (int ai = 0; ai < 2; ++ai)
#pragma unroll
        for (int m = 0; m < 4; ++m)
#pragma unroll
            for (int bj = 0; bj < 2; ++bj)
#pragma unroll
                for (int n = 0; n < 2; ++n)
                    epi_apply<MODE>(e, brow + ai * HALF + wr * 64 + m * 16 + fr, bcol + bj * HALF + wc * 32 + n * 16 + fq * 4, acc[ai][bj][m][n]);
#undef SA
#undef SB
#undef STAGE
#undef LDA
#undef LDB
#undef MMA
}

DEVFN bool tile_of(int i, int nM, int nN, int& pm, int& pn) {
    const int nwg = nM * nN; const long L = (long)i * gridDim.x + BIDX; if (L >= nwg) return false;
    int wgid = (int)L; { const int q = nwg / 8, r = nwg % 8, xcd = wgid % 8, off = wgid / 8; wgid = (xcd < r ? xcd * (q + 1) : r * (q + 1) + (xcd - r) * q) + off; }
    const int nig = 8 * nN, gid = wgid / nig, fm = gid * 8, gsz = (nM - fm) < 8 ? (nM - fm) : 8;
    pm = fm + ((wgid % nig) % gsz); pn = (wgid % nig) / gsz; return true;
}

template <int MODE>
DEVFN void gemm_phase(const bf16_t* A, int lda, const bf16_t* Bt, int ldb, int K, int N, const EpiArgs& e) {
    const int nM = MTOK / BM, nN = N / BM; int pm, pn;
    for (int i = 0; tile_of(i, nM, nN, pm, pn); ++i) gemm_tile<MODE>(A, lda, Bt, ldb, K, pm * BM, pn * BM, e);
}

DEVFN void tr_tile(const float* __restrict__ src, int ld, int Kv, int n0, int Nv, bf16_t* __restrict__ dst, int Kpad, int tk, int tn) {
    float* T = (float*)dyn_lds;
    const int tid = TIDX;
    __syncthreads();
    { const int nn = tid & 63, n = tn * 64 + nn;
#pragma unroll
      for (int i = 0; i < 8; ++i) { const int kk = (tid >> 6) + 8 * i, k = tk * 64 + kk;
          T[kk * 65 + nn] = (k < Kv && n < Nv) ? src[(size_t)k * ld + n0 + n] : 0.f; } }
    __syncthreads();
    { const int kk2 = 2 * (tid & 31);
#pragma unroll
      for (int i = 0; i < 4; ++i) { const int nn2 = (tid >> 5) + 16 * i;
          *(unsigned*)(dst + (size_t)(tn * 64 + nn2) * Kpad + tk * 64 + kk2) = pk2bf(T[kk2 * 65 + nn2], T[(kk2 + 1) * 65 + nn2]); } }
}

DEVFN void weight_prep(KP P, int l, int first_item, int item_stride) {
    unsigned char* ws = P->ws;
    const float* w_in = P->w_in + (size_t)l * DM * D_IN;
    for (int it = first_item; it < 4704; it += item_stride) {
        int t = it;
        if (t < 1024) { tr_tile(w_in, D_IN, DM, 0, 3872, (bf16_t*)(ws + OFF_W1T), DM, t & 15, t >> 4); continue; } t -= 1024;
        if (t < 512)  { tr_tile(w_in, D_IN, DM, 3872, 2048, (bf16_t*)(ws + OFF_WGT), DM, t & 15, t >> 4); continue; } t -= 512;
        if (t < 64)   { tr_tile(P->w_gate_up + (size_t)l * 160 * DM, DM, 160, 0, DM, (bf16_t*)(ws + OFF_WGUT), 256, t & 3, t >> 2); continue; } t -= 64;
        if (t < 16)   { tr_tile(P->w_decay_up + (size_t)l * 64 * DM, DM, 64, 0, DM, (bf16_t*)(ws + OFF_WDT), 64, 0, t); continue; } t -= 16;
        if (t < 16)   { tr_tile(P->w_aaa_up + (size_t)l * 64 * DM, DM, 64, 0, DM, (bf16_t*)(ws + OFF_WAT), 64, 0, t); continue; } t -= 16;
        if (t < 256)  { tr_tile(P->w_rwkv_up + (size_t)l * DM * DM, DM, DM, 0, DM, (bf16_t*)(ws + OFF_WRUT), DM, t & 15, t >> 4); continue; } t -= 256;
        if (t < 256)  { tr_tile(P->w_out + (size_t)l * DM * DM, DM, DM, 0, DM, (bf16_t*)(ws + OFF_WOUTT), DM, t & 15, t >> 4); continue; } t -= 256;
        if (t < 1024) { tr_tile(P->w_ff1 + (size_t)l * DM * DFF, DFF, DM, 0, DFF, (bf16_t*)(ws + OFF_WFF1T), DM, t & 15, t >> 4); continue; } t -= 1024;
        if (t < 1024) { tr_tile(P->w_ff2 + (size_t)l * DFF * DM, DM, DFF, 0, DM, (bf16_t*)(ws + OFF_WFF2T), DFF, t & 63, t >> 6); continue; } t -= 1024;
        {
            const int kk = t, g = kk >> 7;
            const float* mix = P->pool_mix + (size_t)l * 4 * 128 * 128 + (size_t)kk * 128;
            const float* sc = P->pool_scale + (size_t)l * 512 + g * 128;
            const float* wpu = P->w_pool_up + (size_t)l * 512 * DM + (size_t)g * 128 * DM;
            float a0 = 0.f, a1 = 0.f; const int n = TIDX;
            for (int d = 0; d < 128; ++d) { const float s = mix[d] * sc[d]; a0 += s * wpu[(size_t)d * DM + n]; a1 += s * wpu[(size_t)d * DM + n + 512]; }
            bf16_t* dst = (bf16_t*)(ws + OFF_WPUT);
            dst[(size_t)n * 512 + kk] = (bf16_t)(pk2bf(a0, 0.f) & 0xffffu); dst[(size_t)(n + 512) * 512 + kk] = (bf16_t)(pk2bf(a1, 0.f) & 0xffffu);
        }
    }
}

DEVFN void mod_partial(KP P, int item) {
    float* S = (float*)dyn_lds;
    const int kc = item / 48, rest = item % 48, l = rest / 12, j = (rest % 12) * 512 + TIDX;
    __syncthreads();
    for (int i = TIDX; i < 1024; i += NTHR) { const int kk = i >> 3, b = i & 7; const float cv = P->c[b * DM + kc * 128 + kk]; S[i] = cv * sigmoidf_(cv); }
    __syncthreads();
    float acc[8] = {0, 0, 0, 0, 0, 0, 0, 0};
    const float* w = P->w_ada + (size_t)l * DM * 6 * DM + (size_t)(kc * 128) * 6 * DM + j;
#pragma unroll 8
    for (int kk = 0; kk < 128; ++kk) { const float wv = w[(size_t)kk * 6 * DM]; const f32x4 s0 = *(const f32x4*)(S + kk * 8), s1 = *(const f32x4*)(S + kk * 8 + 4);
        acc[0] += wv * s0[0]; acc[1] += wv * s0[1]; acc[2] += wv * s0[2]; acc[3] += wv * s0[3]; acc[4] += wv * s1[0]; acc[5] += wv * s1[1]; acc[6] += wv * s1[2]; acc[7] += wv * s1[3]; }
    float* modp = (float*)(P->ws + OFF_MODP);
#pragma unroll
    for (int b = 0; b < 8; ++b) modp[((size_t)(kc * 4 + l) * 8 + b) * 6 * DM + j] = acc[b];
}

DEVFN void mod_reduce(KP P) {
    const float* modp = (const float*)(P->ws + OFF_MODP); float* mod = (float*)(P->ws + OFF_MOD);
    for (int idx = BIDX * NTHR + TIDX; idx < 4 * 8 * 6 * DM; idx += gridDim.x * NTHR) {
        const int j = idx % (6 * DM), l = idx / (8 * 6 * DM);
        float s = P->b_ada[l * 6 * DM + j];
#pragma unroll
        for (int kc = 0; kc < 8; ++kc) s += modp[(size_t)kc * 4 * 8 * 6 * DM + idx];
        mod[idx] = s;
    }
}

DEVFN void modulate_phase(const float* __restrict__ x, const float* __restrict__ modl, int kshift, bf16_t* __restrict__ h) {
    for (size_t i = (size_t)BIDX * NTHR + TIDX; i < (size_t)MTOK * DM / 4; i += (size_t)gridDim.x * NTHR) {
        const size_t e = i * 4; const int row = (int)(e >> 10), col = (int)(e & 1023), b = row >> 12;
        const f32x4 xv = *(const f32x4*)(x + e);
        const f32x4 sh = *(const f32x4*)(modl + (size_t)b * 6 * DM + kshift * DM + col), sc = *(const f32x4*)(modl + (size_t)b * 6 * DM + (kshift + 1) * DM + col);
        u32x2 w; w.x = pk2bf(xv[0] * (1.f + sc[0]) + sh[0], xv[1] * (1.f + sc[1]) + sh[1]); w.y = pk2bf(xv[2] * (1.f + sc[2]) + sh[2], xv[3] * (1.f + sc[3]) + sh[3]);
        *(u32x2*)(h + e) = w;
    }
}

DEVFN void ln_phase(float* __restrict__ xy, const float* __restrict__ g, const float* __restrict__ bb, const float* __restrict__ modl, int kshift, bf16_t* __restrict__ h) {
    const int wv = TIDX >> 6, lane = TIDX & 63;
    for (int row = BIDX * 8 + wv; row < MTOK; row += gridDim.x * 8) {
        float* p = xy + (size_t)row * DM;
        f32x4 v[4]; float s = 0.f;
#pragma unroll
        for (int i = 0; i < 4; ++i) { v[i] = *(const f32x4*)(p + i * 256 + lane * 4); s += (v[i][0] + v[i][1]) + (v[i][2] + v[i][3]); }
        s = wave_sum(s); const float mean = s * (1.0f / DM);
        float q = 0.f;
#pragma unroll
        for (int i = 0; i < 4; ++i) { const f32x4 d = v[i] - mean; q += (d[0] * d[0] + d[1] * d[1]) + (d[2] * d[2] + d[3] * d[3]); }
        q = wave_sum(q); const float rstd = rsqrtf(q * (1.0f / DM) + LN_EPS);
        const int b = row >> 12;
#pragma unroll
        for (int i = 0; i < 4; ++i) {
            const int col = i * 256 + lane * 4;
            const f32x4 gv = *(const f32x4*)(g + col), bv = *(const f32x4*)(bb + col);
            f32x4 o; for (int j = 0; j < 4; ++j) o[j] = (v[i][j] - mean) * rstd * gv[j] + bv[j];
            *(f32x4*)(p + col) = o;
            if (h) {
                const f32x4 sh = *(const f32x4*)(modl + (size_t)b * 6 * DM + kshift * DM + col), sc = *(const f32x4*)(modl + (size_t)b * 6 * DM + (kshift + 1) * DM + col);
                u32x2 w; w.x = pk2bf(o[0] * (1.f + sc[0]) + sh[0], o[1] * (1.f + sc[1]) + sh[1]); w.y = pk2bf(o[2] * (1.f + sc[2]) + sh[2], o[3] * (1.f + sc[3]) + sh[3]);
                *(u32x2*)(h + (size_t)row * DM + col) = w;
            }
        }
    }
}

constexpr int SC_VEC = 0, SC_P = 81920, SC_TWXA = SC_P + 34816, SC_VB = SC_TWXA + 18432, SC_OB = SC_VB + 8192, SC_SC = SC_OB + 8192, SC_PAR = SC_SC + 1024;

DEVFN void scan_unit(KP P, int l, int unit) {
    const int q = unit >> 4, half = (unit >> 3) & 1, xx = unit & 7, head = q * 8 + xx, b = head >> 4, h = head & 15;
    const int tid = TIDX, wv = tid >> 6, lane = tid & 63;
    float* VEC = (float*)(dyn_lds + SC_VEC);
    float* PP = (float*)(dyn_lds + SC_P);
    unsigned char* TWXA = dyn_lds + SC_TWXA;
    float* VB = (float*)(dyn_lds + SC_VB);
    float* OB = (float*)(dyn_lds + SC_OB);
    float* SCB = (float*)(dyn_lds + SC_SC);
    float* PAR = (float*)(dyn_lds + SC_PAR);
    const bf16_t* p = (const bf16_t*)(P->ws + OFF_P);
    bf16_t* obuf = (bf16_t*)(P->ws + OFF_O);
    float* bonus = (float*)(P->ws + OFF_BONUS);
    __syncthreads();
    for (int i = tid; i < 640; i += NTHR) {
        const int a = i >> 6, cix = i & 63; float v;
        const float* mu = P->mu_shift + (size_t)l * D_SH;
        if (a == 0) v = mu[h * 64 + cix]; else if (a == 1) v = mu[1024 + h * 64 + cix]; else if (a == 2) v = mu[2048 + h * 64 + cix];
        else if (a == 3) v = mu[3072 + cix]; else if (a == 4) v = mu[3136 + cix];
        else if (a == 5) v = P->w0[l * DM + h * 64 + cix]; else if (a == 6) v = P->a0[l * DM + h * 64 + cix];
        else if (a == 7) v = P->k_k[l * DM + h * 64 + cix]; else if (a == 8) v = P->k_a[l * DM + h * 64 + cix]; else v = P->r_k[l * DM + h * 64 + cix];
        PAR[i] = v;
    }
    const int mtx = wv >> 2, rt = wv & 3, fr = lane & 15, fq = lane >> 4;
    bf16x8 bfrag[4][2];
    { const bf16_t* wt = (const bf16_t*)(P->ws + (mtx ? OFF_WAT : OFF_WDT));
#pragma unroll
      for (int ct = 0; ct < 4; ++ct)
#pragma unroll
          for (int ks = 0; ks < 2; ++ks) bfrag[ct][ks] = *(const bf16x8*)(wt + (size_t)(h * 64 + ct * 16 + fr) * 64 + ks * 32 + fq * 8); }
    const int t = tid >> 3, part = tid & 7, c8 = part * 8;
    const int rl = lane >> 4, kseg = lane & 15, myrow = 4 * wv + rl;
    f32x4 S = {0.f, 0.f, 0.f, 0.f};
    __syncthreads();
    for (int chunk = 0; chunk < SEQ / 64; ++chunk) {
        const int tseq = chunk * 64 + t; const size_t tok = (size_t)b * SEQ + tseq;
        float r[8], k[8], v[8];
        {
            const bf16_t* pr = p + tok * NP1;
            const bool hasprev = tseq > 0;
            float cur[8], prv[8];
#define LOADMIX(dst, col, muoff) { const u32x4 uc = *(const u32x4*)(pr + (col)); unpack8(uc, cur); \
            if (hasprev) { const u32x4 up = *(const u32x4*)(pr - NP1 + (col)); unpack8(up, prv); } else { for (int j = 0; j < 8; ++j) prv[j] = 0.f; } \
            for (int j = 0; j < 8; ++j) dst[j] = cur[j] + (prv[j] - cur[j]) * PAR[(muoff) * 64 + c8 + j]; }
            float xw[8], xa[8];
            LOADMIX(r, 512 + h * 64 + c8, 0);
            LOADMIX(k, 512 + 1024 + h * 64 + c8, 1);
            LOADMIX(v, 512 + 2048 + h * 64 + c8, 2);
            LOADMIX(xw, 3584 + c8, 3);
            LOADMIX(xa, 3648 + c8, 4);
#undef LOADMIX
            u32x4 tw, ta;
            tw.x = pk2bf(tanhf(xw[0]), tanhf(xw[1])); tw.y = pk2bf(tanhf(xw[2]), tanhf(xw[3])); tw.z = pk2bf(tanhf(xw[4]), tanhf(xw[5])); tw.w = pk2bf(tanhf(xw[6]), tanhf(xw[7]));
            ta.x = pk2bf(xa[0], xa[1]); ta.y = pk2bf(xa[2], xa[3]); ta.z = pk2bf(xa[4], xa[5]); ta.w = pk2bf(xa[6], xa[7]);
            *(u32x4*)(TWXA + t * 144 + c8 * 2) = tw;
            *(u32x4*)(TWXA + 9216 + t * 144 + c8 * 2) = ta;
        }
        __syncthreads();
        {
            const unsigned char* ab = TWXA + mtx * 9216 + (rt * 16 + fr) * 144 + fq * 16;
            const bf16x8 a0 = *(const bf16x8*)(ab), a1 = *(const bf16x8*)(ab + 64);
#pragma unroll
            for (int ct = 0; ct < 4; ++ct) {
                f32x4 acc = {0.f, 0.f, 0.f, 0.f};
                acc = __builtin_amdgcn_mfma_f32_16x16x32_bf16(a0, bfrag[ct][0], acc, 0, 0, 0);
                acc = __builtin_amdgcn_mfma_f32_16x16x32_bf16(a1, bfrag[ct][1], acc, 0, 0, 0);
#pragma unroll
                for (int j = 0; j < 4; ++j) PP[mtx * 4352 + (rt * 16 + fq * 4 + j) * 68 + ct * 16 + fr] = acc[j];
            }
        }
        __syncthreads();
        {
            const f32x4 d0 = *(const f32x4*)(PP + t * 68 + c8), d1 = *(const f32x4*)(PP + t * 68 + c8 + 4);
            const f32x4 e0 = *(const f32x4*)(PP + 4352 + t * 68 + c8), e1 = *(const f32x4*)(PP + 4352 + t * 68 + c8 + 4);
            float dp[8] = {d0[0], d0[1], d0[2], d0[3], d1[0], d1[1], d1[2], d1[3]}, ap[8] = {e0[0], e0[1], e0[2], e0[3], e1[0], e1[1], e1[2], e1[3]};
            float kkr[8], ss = 0.f;
#pragma unroll
            for (int j = 0; j < 8; ++j) { kkr[j] = k[j] * PAR[7 * 64 + c8 + j]; ss += kkr[j] * kkr[j]; }
            ss = oct_sum(ss);
            const float inv = 1.0f / fmaxf(sqrtf(ss), 1e-12f);
            float va[8], vw[8], vb[8], vk[8], vwr[8], br = 0.f, kr = 0.f, bo = 0.f;
#pragma unroll
            for (int j = 0; j < 8; ++j) {
                const float wpre = PAR[5 * 64 + c8 + j] + dp[j];
                const float z = -wpre;
                const float sp = fmaxf(z, 0.f) + log1pf(__expf(-fabsf(z)));
                const float w = -sp - 0.5f;
                const float dec = __expf(-__expf(w));
                const float alr = sigmoidf_(PAR[6 * 64 + c8 + j] + ap[j]);
                const float kk = kkr[j] * inv;
                const float kn = k[j] * (1.0f + (alr - 1.0f) * PAR[8 * 64 + c8 + j]);
                va[j] = -kk; vb[j] = kk * alr; vw[j] = dec; vk[j] = kn; vwr[j] = dec * r[j];
                br += vb[j] * r[j]; kr += kn * r[j]; bo += r[j] * kn * PAR[9 * 64 + c8 + j];
            }
            br = oct_sum(br); kr = oct_sum(kr); bo = oct_sum(bo);
            float* vt = VEC + t * 320 + c8;
            *(f32x4*)(vt) = (f32x4){va[0], va[1], va[2], va[3]};        *(f32x4*)(vt + 4) = (f32x4){va[4], va[5], va[6], va[7]};
            *(f32x4*)(vt + 64) = (f32x4){vw[0], vw[1], vw[2], vw[3]};   *(f32x4*)(vt + 68) = (f32x4){vw[4], vw[5], vw[6], vw[7]};
            *(f32x4*)(vt + 128) = (f32x4){vb[0], vb[1], vb[2], vb[3]};  *(f32x4*)(vt + 132) = (f32x4){vb[4], vb[5], vb[6], vb[7]};
            *(f32x4*)(vt + 192) = (f32x4){vk[0], vk[1], vk[2], vk[3]};  *(f32x4*)(vt + 196) = (f32x4){vk[4], vk[5], vk[6], vk[7]};
            *(f32x4*)(vt + 256) = (f32x4){vwr[0], vwr[1], vwr[2], vwr[3]}; *(f32x4*)(vt + 260) = (f32x4){vwr[4], vwr[5], vwr[6], vwr[7]};
            if ((part >> 2) == half) { float* vbp = VB + t * 32 + (c8 & 31); *(f32x4*)(vbp) = (f32x4){v[0], v[1], v[2], v[3]}; *(f32x4*)(vbp + 4) = (f32x4){v[4], v[5], v[6], v[7]}; }
            if (part == 0) { SCB[t * 4] = br; SCB[t * 4 + 1] = kr; if (half == 0) bonus[tok * 16 + h] = bo; }
        }
        __syncthreads();
#pragma unroll 4
        for (int tt = 0; tt < 64; ++tt) {
            const float* vb = VEC + tt * 320 + 4 * kseg;
            const f32x4 a4 = *(const f32x4*)(vb), w4 = *(const f32x4*)(vb + 64), b4 = *(const f32x4*)(vb + 128), k4 = *(const f32x4*)(vb + 192), wr4 = *(const f32x4*)(vb + 256);
            const float vv = VB[tt * 32 + myrow]; const float brs = SCB[tt * 4], krs = SCB[tt * 4 + 1];
            float sa = (S[0] * a4[0] + S[1] * a4[1]) + (S[2] * a4[2] + S[3] * a4[3]);
            float op = (S[0] * wr4[0] + S[1] * wr4[1]) + (S[2] * wr4[2] + S[3] * wr4[3]);
            sa = row16_sum(sa); op = row16_sum(op);
#pragma unroll
            for (int j = 0; j < 4; ++j) S[j] = S[j] * w4[j] + (sa * b4[j] + vv * k4[j]);
            const float o = op + sa * brs + vv * krs;
            if (kseg == 0) OB[tt * 32 + myrow] = o;
        }
        __syncthreads();
        {
            const f32x4 ov = *(const f32x4*)(OB + t * 32 + part * 4);
            u32x2 w; w.x = pk2bf(ov[0], ov[1]); w.y = pk2bf(ov[2], ov[3]);
            *(u32x2*)(obuf + tok * DM + h * 64 + half * 32 + part * 4) = w;
        }
    }
}

DEVFN void elem_phase(KP P, int l) {
    const bf16_t* p = (const bf16_t*)(P->ws + OFF_P);
    bf16_t* mb = (bf16_t*)(P->ws + OFF_MB); bf16_t* ga = (bf16_t*)(P->ws + OFF_GA); bf16_t* ob = (bf16_t*)(P->ws + OFF_O);
    const float* bonus = (const float*)(P->ws + OFF_BONUS);
    const float* mu = P->mu_shift + (size_t)l * D_SH;
    const int tid = TIDX;
    for (int blk = BIDX; blk < MTOK / 16; blk += gridDim.x) {
        const int tok0 = blk * 16;
#pragma unroll 1
        for (int rep = 0; rep < 2; ++rep) {
            const int idx = tid + rep * NTHR, tl = idx >> 6, cg8 = (idx & 63) * 8, tok = tok0 + tl, tseq = tok & (SEQ - 1);
            const int win = 2 << (cg8 >> 7); const int cnt = (tseq + 1) < win ? (tseq + 1) : win;
            float acc[8] = {0, 0, 0, 0, 0, 0, 0, 0}, self[8], tmp[8];
            const bf16_t* src = p + (size_t)tok * NP1 + cg8;
            unpack8(*(const u32x4*)src, self);
            for (int j = 0; j < 8; ++j) acc[j] = self[j];
            for (int s = 1; s < cnt; ++s) { unpack8(*(const u32x4*)(src - (size_t)s * NP1), tmp); for (int j = 0; j < 8; ++j) acc[j] += tmp[j]; }
            const float ic = 1.0f / (float)cnt;
            u32x4 w; w.x = pk2bf(acc[0] * ic - self[0], acc[1] * ic - self[1]); w.y = pk2bf(acc[2] * ic - self[2], acc[3] * ic - self[3]);
            w.z = pk2bf(acc[4] * ic - self[4], acc[5] * ic - self[5]); w.w = pk2bf(acc[6] * ic - self[6], acc[7] * ic - self[7]);
            *(u32x4*)(mb + (size_t)tok * 512 + cg8) = w;
        }
        {
            const int tl = tid >> 5, c8 = (tid & 31) * 8, tok = tok0 + tl, tseq = tok & (SEQ - 1);
            u32x4 w = {0u, 0u, 0u, 0u};
            if (c8 < 160) {
                float cur[8], prv[8], o[8];
                const bf16_t* src = p + (size_t)tok * NP1 + 3712 + c8;
                unpack8(*(const u32x4*)src, cur);
                if (tseq > 0) unpack8(*(const u32x4*)(src - NP1), prv); else { for (int j = 0; j < 8; ++j) prv[j] = 0.f; }
                for (int j = 0; j < 8; ++j) o[j] = sigmoidf_(cur[j] + (prv[j] - cur[j]) * mu[3200 + c8 + j]);
                w.x = pk2bf(o[0], o[1]); w.y = pk2bf(o[2], o[3]); w.z = pk2bf(o[4], o[5]); w.w = pk2bf(o[6], o[7]);
            }
            *(u32x4*)(ga + (size_t)tok * 256 + c8) = w;
        }
#pragma unroll 1
        for (int rep = 0; rep < 4; ++rep) {
            const int idx = tid + rep * NTHR, tl = idx >> 7, hh = (idx >> 3) & 15, part = idx & 7, tok = tok0 + tl, tseq = tok & (SEQ - 1);
            const int ch = hh * 64 + part * 8;
            float o[8], cur[8], prv[8];
            bf16_t* op = ob + (size_t)tok * DM + ch;
            unpack8(*(const u32x4*)op, o);
            float s = 0.f; for (int j = 0; j < 8; ++j) s += o[j];
            s = oct_sum(s); const float mean = s * (1.0f / 64.0f);
            float qv = 0.f; for (int j = 0; j < 8; ++j) { const float d = o[j] - mean; qv += d * d; }
            qv = oct_sum(qv); const float rstd = rsqrtf(qv * (1.0f / 64.0f) + GN_EPS);
            const bf16_t* src = p + (size_t)tok * NP1 + 512 + 2048 + ch;
            unpack8(*(const u32x4*)src, cur);
            if (tseq > 0) unpack8(*(const u32x4*)(src - NP1), prv); else { for (int j = 0; j < 8; ++j) prv[j] = 0.f; }
            const float bo = bonus[(size_t)tok * 16 + hh];
            float res[8];
            for (int j = 0; j < 8; ++j) {
                const float vv = cur[j] + (prv[j] - cur[j]) * mu[2048 + ch + j];
                res[j] = (o[j] - mean) * rstd * P->gn_g[l * DM + ch + j] + P->gn_b[l * DM + ch + j] + bo * vv;
            }
            u32x4 w; w.x = pk2bf(res[0], res[1]); w.y = pk2bf(res[2], res[3]); w.z = pk2bf(res[4], res[5]); w.w = pk2bf(res[6], res[7]);
            *(u32x4*)op = w;
        }
    }
}

constexpr int PH_PRE = 3, PH_PER_LAYER = 10, N_PHASES = PH_PRE + DEPTH * PH_PER_LAYER;

DEVFN void run_phase(KP P, int ph) {
    unsigned char* ws = P->ws; asm volatile("" : "+s"(ws));
    const float* mod = (const float*)(ws + OFF_MOD);
    bf16_t* hbuf = (bf16_t*)(ws + OFF_H);
    if (ph == 0) {
        for (int it = BIDX; it < 384; it += gridDim.x) mod_partial(P, it);
        int first = (int)BIDX - (384 % (int)gridDim.x); if (first < 0) first += gridDim.x;
        weight_prep(P, 0, first, gridDim.x);
        return;
    }
    if (ph == 1) { mod_reduce(P); return; }
    if (ph == 2) { modulate_phase(P->x, mod, 0, hbuf); return; }
    const int l = (ph - PH_PRE) / PH_PER_LAYER, s = (ph - PH_PRE) % PH_PER_LAYER;
    const float* modl = mod + (size_t)l * 8 * 6 * DM;
    EpiArgs e{};
    switch (s) {
    case 0: {
        e.o16 = (bf16_t*)(ws + OFF_P); e.ld = NP1;
        gemm_phase<0>(hbuf, DM, (const bf16_t*)(ws + OFF_W1T), DM, DM, NP1, e);
    } break;
    case 1: {
        for (int u = BIDX; u < 256; u += gridDim.x) scan_unit(P, l, u);
    } break;
    case 2: elem_phase(P, l); break;
    case 3: {
        e.o16 = (bf16_t*)(ws + OFF_O); e.ld = DM;
        gemm_phase<1>((const bf16_t*)(ws + OFF_GA), 256, (const bf16_t*)(ws + OFF_WGUT), 256, 256, DM, e);
    } break;
    case 4: {
        e.ld = DM; e.o16 = (bf16_t*)(ws + OFF_MIX); e.o16b = (const bf16_t*)(ws + OFF_TMP);
        EpiArgs e2{}; e2.ld = DM; e2.o16 = (bf16_t*)(ws + OFF_TMP);
        gemm_phase<2>(hbuf, DM, (const bf16_t*)(ws + OFF_WGT) + (size_t)DM * DM, DM, DM, DM, e2);
        gemm_phase<2>(hbuf, DM, (const bf16_t*)(ws + OFF_WGT), DM, DM, DM, e);
        gemm_phase<3>((const bf16_t*)(ws + OFF_MB), 512, (const bf16_t*)(ws + OFF_WPUT), 512, 512, DM, e);
        gemm_phase<4>((const bf16_t*)(ws + OFF_O), DM, (const bf16_t*)(ws + OFF_WRUT), DM, DM, DM, e);
    } break;
    case 5: {
        e.xsrc = (l == 0) ? P->x : P->out; e.y = P->out; e.gate = modl + 2 * DM;
        gemm_phase<5>((const bf16_t*)(ws + OFF_MIX), DM, (const bf16_t*)(ws + OFF_WOUTT), DM, DM, DM, e);
    } break;
    case 6: ln_phase(P->out, P->ln1_g + l * DM, P->ln1_b + l * DM, modl, 3, hbuf); break;
    case 7: {
        e.o16 = (bf16_t*)(ws + OFF_HID); e.ld = DFF;
        gemm_phase<6>(hbuf, DM, (const bf16_t*)(ws + OFF_WFF1T), DM, DM, DFF, e);
    } break;
    case 8: {
        e.xsrc = P->out; e.y = P->out; e.gate = modl + 5 * DM;
        gemm_phase<5>((const bf16_t*)(ws + OFF_HID), DFF, (const bf16_t*)(ws + OFF_WFF2T), DFF, DFF, DM, e);
    } break;
    case 9: {
        if (l + 1 < DEPTH) { ln_phase(P->out, P->ln2_g + l * DM, P->ln2_b + l * DM, modl + 8 * 6 * DM, 0, hbuf); weight_prep(P, l + 1, BIDX, gridDim.x); }
        else ln_phase(P->out, P->ln2_g + l * DM, P->ln2_b + l * DM, modl, 0, (bf16_t*)nullptr);
    } break;
    }
}

__global__ void __launch_bounds__(NTHR, 2) mega_kernel(Params Parg, int ph0, int ph1) {
    cg::grid_group grid = cg::this_grid();
    for (int ph = ph0; ph < ph1; ++ph) {
        KP P = (KP)__builtin_amdgcn_kernarg_segment_ptr(); asm volatile("" : "+s"(P));
        run_phase(P, ph);
        if (ph + 1 < ph1) grid.sync();
    }
}

#ifndef DBG_STOP
#define DBG_STOP 0
#endif
__global__ void dbg_dump(const unsigned char* ws, size_t off, float* out) {
    const bf16_t* b = (const bf16_t*)(ws + off);
    for (size_t i = (size_t)blockIdx.x * blockDim.x + threadIdx.x; i < (size_t)MTOK * DM; i += (size_t)gridDim.x * blockDim.x)
        out[i] = __uint_as_float((unsigned)b[i] << 16);
}
extern "C" void kernel_launch(void* const* d_in, const int* in_sizes, int n_in, void* d_out, int out_size, void* d_ws, size_t ws_size,
                              hipStream_t stream) {
    static int grid_blocks = 0;
    if (!grid_blocks) {
        hipFuncSetAttribute((const void*)mega_kernel, hipFuncAttributeMaxDynamicSharedMemorySize, LDS_BYTES);
        int dev = 0, cus = 0, per_cu = 0;
        hipGetDevice(&dev);
        hipDeviceGetAttribute(&cus, hipDeviceAttributeMultiprocessorCount, dev);
        hipOccupancyMaxActiveBlocksPerMultiprocessor(&per_cu, mega_kernel, NTHR, LDS_BYTES);
        if (per_cu < 1) per_cu = 1;
        grid_blocks = cus * per_cu;
    }
    Params p{};
    const float** pp = (const float**)&p;
    for (int i = 0; i < 27; ++i) pp[i] = (const float*)d_in[i];
    p.out = (float*)d_out; p.ws = (unsigned char*)d_ws;
#if SINGLE_LAUNCH
    int ph0 = 0, ph1 = N_PHASES;
    void* args[] = {&p, &ph0, &ph1};
    hipError_t e = hipLaunchCooperativeKernel((const void*)mega_kernel, dim3(grid_blocks), dim3(NTHR), args, LDS_BYTES, stream);
    if (e != hipSuccess) fprintf(stderr, "cooperative launch failed: %s (grid %d)\n", hipGetErrorString(e), grid_blocks);
#else
    const int nph = DBG_STOP ? DBG_STOP : N_PHASES;
    for (int ph = 0; ph < nph; ++ph) mega_kernel<<<dim3(grid_blocks), dim3(NTHR), LDS_BYTES, stream>>>(p, ph, ph + 1);
    if (DBG_STOP) dbg_dump<<<1024, 256, 0, stream>>>((const unsigned char*)d_ws, DBG_OFF, (float*)d_out);
#endif
}
```

```cpp
#include <hip/hip_runtime.h>
#include <hip/hip_cooperative_groups.h>
#include <cstdio>
namespace cg = cooperative_groups;

#define DBG_OFF OFF_TMP
#ifndef SINGLE_LAUNCH
#define SINGLE_LAUNCH 1
#endif

typedef unsigned short bf16_t;
typedef short bf16x8 __attribute__((ext_vector_type(8)));
typedef float f32x4 __attribute__((ext_vector_type(4)));
typedef unsigned u32x4 __attribute__((ext_vector_type(4)));
typedef unsigned u32x2 __attribute__((ext_vector_type(2)));

#define DEVFN __device__ __forceinline__

constexpr int DM = 1024, NB = 8, SEQ = 4096, DEPTH = 4, MTOK = NB * SEQ;
constexpr int D_IN = 5920, D_SH = 3360, NP1 = 4096;
constexpr int DFF = 4096;
constexpr float ALPHA = 1.681792830507429f;
constexpr float LN_EPS = 1e-5f, GN_EPS = 64e-5f;
constexpr int NTHR = 512;

constexpr size_t MiB = 1024 * 1024;
constexpr size_t OFF_W1T = 0, OFF_WGT = 8 * MiB, OFF_WPUT = 12 * MiB, OFF_WGUT = 13 * MiB, OFF_WDT = 13 * MiB + 512 * 1024,
                 OFF_WAT = 13 * MiB + 640 * 1024, OFF_WRUT = 14 * MiB, OFF_WOUTT = 16 * MiB, OFF_WFF1T = 18 * MiB, OFF_WFF2T = 26 * MiB,
                 OFF_MOD = 34 * MiB, OFF_MODP = 35 * MiB, OFF_BONUS = 41 * MiB, OFF_BAR = 43 * MiB, OFF_P = 44 * MiB,
                 OFF_H = 300 * MiB, OFF_O = 364 * MiB, OFF_MB = 428 * MiB, OFF_GA = 460 * MiB;
constexpr size_t OFF_MIX = OFF_P, OFF_TMP = OFF_P + 64 * MiB, OFF_HID = OFF_P;

struct Params {
    const float *x, *c, *w_ada, *b_ada, *w_in, *mu_shift, *pool_mix, *pool_scale, *w_pool_up, *w0, *w_decay_up, *a0, *w_aaa_up,
        *w_gate_up, *k_k, *k_a, *r_k, *gn_g, *gn_b, *w_rwkv_up, *w_out, *ln1_g, *ln1_b, *w_ff1, *w_ff2, *ln2_g, *ln2_b;
    float* out;
    unsigned char* ws;
};

typedef const __attribute__((address_space(4))) Params* KP;
extern __shared__ __attribute__((aligned(16))) unsigned char dyn_lds[];
constexpr int LDS_BYTES = 155136;

DEVFN int opaque_tid() { int t; asm volatile("v_mov_b32 %0, %1" : "=v"(t) : "v"(threadIdx.x)); return t; }
DEVFN int opaque_bid() { int t; asm volatile("s_mov_b32 %0, %1" : "=s"(t) : "s"(blockIdx.x)); return t; }
#define TIDX opaque_tid()
#define BIDX opaque_bid()
typedef float f32x2 __attribute__((ext_vector_type(2)));
typedef __bf16 bf16x2_t __attribute__((ext_vector_type(2)));
DEVFN unsigned pk2bf(float lo, float hi) { const f32x2 v = {lo, hi}; const bf16x2_t b = __builtin_convertvector(v, bf16x2_t); return __builtin_bit_cast(unsigned, b); }
DEVFN float bflo(unsigned u) { return __uint_as_float(u << 16); }
DEVFN float bfhi(unsigned u) { return __uint_as_float(u & 0xffff0000u); }
DEVFN void unpack8(const u32x4 u, float* f) {
    f[0] = bflo(u.x); f[1] = bfhi(u.x); f[2] = bflo(u.y); f[3] = bfhi(u.y); f[4] = bflo(u.z); f[5] = bfhi(u.z); f[6] = bflo(u.w); f[7] = bfhi(u.w);
}
DEVFN float sigmoidf_(float x) { return __builtin_amdgcn_rcpf(1.0f + __expf(-x)); }
DEVFN float tanh_fast(float x) { return 1.0f - 2.0f * __builtin_amdgcn_rcpf(1.0f + __expf(2.0f * x)); }
template <int CTRL> DEVFN float dpp_f(float v) { return __int_as_float(__builtin_amdgcn_update_dpp(0, __float_as_int(v), CTRL, 0xF, 0xF, true)); }
DEVFN float row16_sum(float v) {
    v += dpp_f<0xB1>(v); v += dpp_f<0x4E>(v); v += dpp_f<0x141>(v); v += dpp_f<0x140>(v); return v;
}
DEVFN float oct_sum(float v) {
    v += dpp_f<0xB1>(v); v += dpp_f<0x4E>(v); v += dpp_f<0x141>(v); return v;
}
DEVFN float wave_sum(float v) {
    v = row16_sum(v);
    const int vi = __float_as_int(v);
    return (__int_as_float(__builtin_amdgcn_readlane(vi, 0)) + __int_as_float(__builtin_amdgcn_readlane(vi, 16))) +
           (__int_as_float(__builtin_amdgcn_readlane(vi, 32)) + __int_as_float(__builtin_amdgcn_readlane(vi, 48)));
}

constexpr int BM = 256, BK = 64, HALF = 128, HT = HALF * BK;
DEVFN int lds_byte(int r, int c) { int st = (r >> 4) * 2 + (c >> 5), rr = r & 15, cc = c & 31, ob = rr * 64 + cc * 2; return st * 1024 + (ob ^ (((ob >> 9) & 1) << 5)); }
DEVFN void stage_rc(int b, int& R, int& C) { int st = b / 1024, sb = b % 1024, swz = sb ^ (((sb >> 9) & 1) << 5); R = (st >> 1) * 16 + swz / 64; C = (st & 1) * 32 + (swz % 64) / 2; }

struct EpiArgs { bf16_t* o16; const bf16_t* o16b; const float* xsrc; float* y; const float* gate; int ld; };

template <int MODE> DEVFN void epi_apply(const EpiArgs& e, int row, int col, f32x4 v) {
    if (MODE == 0) {
        u32x2 w; w.x = pk2bf(v[0], v[1]); w.y = pk2bf(v[2], v[3]);
        *(u32x2*)(e.o16 + (size_t)row * e.ld + col) = w;
    } else if (MODE == 1 || MODE == 3) {
        u32x2* p = (u32x2*)(e.o16 + (size_t)row * e.ld + col); u32x2 o = *p;
        u32x2 w; w.x = pk2bf(bflo(o.x) * v[0], bfhi(o.x) * v[1]); w.y = pk2bf(bflo(o.y) * v[2], bfhi(o.y) * v[3]); *p = w;
    } else if (MODE == 2) {
        u32x2 w; w.x = pk2bf(sigmoidf_(v[0]), sigmoidf_(v[1])); w.y = pk2bf(sigmoidf_(v[2]), sigmoidf_(v[3]));
        *(u32x2*)(e.o16 + (size_t)row * e.ld + col) = w;
    } else if (MODE == 4) {
        u32x2* p = (u32x2*)(e.o16 + (size_t)row * e.ld + col); u32x2 o = *p; const u32x2 t = *(const u32x2*)(e.o16b + (size_t)row * e.ld + col);
        u32x2 w; w.x = pk2bf(bflo(o.x) + bflo(t.x) * v[0], bfhi(o.x) + bfhi(t.x) * v[1]); w.y = pk2bf(bflo(o.y) + bflo(t.y) * v[2], bfhi(o.y) + bfhi(t.y) * v[3]); *p = w;
    } else if (MODE == 5) {
        const f32x4 xv = *(const f32x4*)(e.xsrc + (size_t)row * DM + col);
        const f32x4 g = *(const f32x4*)(e.gate + (size_t)(row >> 12) * (6 * DM) + col);
        f32x4 o; for (int j = 0; j < 4; ++j) o[j] = ALPHA * xv[j] + (1.0f + g[j]) * v[j];
        *(f32x4*)(e.y + (size_t)row * DM + col) = o;
    } else if (MODE == 6) {
        float r0 = fmaxf(v[0], 0.f), r1 = fmaxf(v[1], 0.f), r2 = fmaxf(v[2], 0.f), r3 = fmaxf(v[3], 0.f);
        u32x2 w; w.x = pk2bf(r0 * r0, r1 * r1); w.y = pk2bf(r2 * r2, r3 * r3);
        *(u32x2*)(e.o16 + (size_t)row * e.ld + col) = w;
    }
}

#define LAS __attribute__((address_space(3)))
template <int MODE>
DEVFN void gemm_tile(const bf16_t* __restrict__ A, const int lda, const bf16_t* __restrict__ Bt, const int ldb, const int K,
                     const int brow, const int bcol, const EpiArgs& e) {
    LAS unsigned char* lds = (LAS unsigned char*)dyn_lds;
    constexpr int HTB = HT * 2;
    const int tid = TIDX, wid = __builtin_amdgcn_readfirstlane(tid >> 6), lane = tid & 63, wr = wid >> 2, wc = wid & 3, fr = lane & 15, fq = lane >> 4;
    unsigned voffA[2], voffB[2];
#pragma unroll
    for (int i = 0; i < 2; ++i) { int R, C; stage_rc(tid * 16 + i * 8192, R, C); voffA[i] = (unsigned)(R * lda + C) * 2u; voffB[i] = (unsigned)(R * ldb + C) * 2u; }
    const size_t kstep = (size_t)(BK * 2), hstepA = (size_t)HALF * lda * 2, hstepB = (size_t)HALF * ldb * 2;
    const unsigned ldsw = (unsigned)wid * 1024u;
    const int aoff = lds_byte(wr * 64 + fr, fq * 8), boff = lds_byte(wc * 32 + fr, fq * 8);
#define SA(b, h) (((b) * 2 + (h)) * HTB)
#define SB(b, h) ((4 + (b) * 2 + (h)) * HTB)
#define STAGE(bufoff, gbase, voff) do { _Pragma("unroll") for (int _i = 0; _i < 2; ++_i) \
    __builtin_amdgcn_global_load_lds((const unsigned*)((const char*)(gbase) + (voff)[_i]), (LAS unsigned*)(lds + (bufoff) + ldsw + _i * 8192), 16, 0, 0); } while (0)
#define LDA(dst, b, h) do { _Pragma("unroll") for (int m = 0; m < 4; ++m) _Pragma("unroll") for (int k = 0; k < 2; ++k) dst[m][k] = *(const LAS bf16x8*)(lds + SA(b, h) + aoff + m * 2048 + k * 1024); } while (0)
#define LDB(dst, b, h) do { _Pragma("unroll") for (int n = 0; n < 2; ++n) _Pragma("unroll") for (int k = 0; k < 2; ++k) dst[n][k] = *(const LAS bf16x8*)(lds + SB(b, h) + boff + n * 2048 + k * 1024); } while (0)
#define MMA(ai, bj, At_, Bt_) do { __builtin_amdgcn_s_setprio(1); \
    _Pragma("unroll") for (int m = 0; m < 4; ++m) _Pragma("unroll") for (int n = 0; n < 2; ++n) _Pragma("unroll") for (int k = 0; k < 2; ++k) \
      acc[ai][bj][m][n] = __builtin_amdgcn_mfma_f32_16x16x32_bf16(Bt_[n][k], At_[m][k], acc[ai][bj][m][n], 0, 0, 0); \
    __builtin_amdgcn_s_setprio(0); } while (0)
#define WAIT_V(n) asm volatile("s_waitcnt vmcnt(" #n ")" ::: "memory")
#define WAIT_L(n) asm volatile("s_waitcnt lgkmcnt(" #n ")" ::: "memory")
#define BAR __builtin_amdgcn_s_barrier()
#define SCHED __builtin_amdgcn_sched_barrier(0)
    f32x4 acc[2][2][4][2];
#pragma unroll
    for (int a = 0; a < 2; ++a)
#pragma unroll
        for (int b = 0; b < 2; ++b)
#pragma unroll
            for (int m = 0; m < 4; ++m)
#pragma unroll
                for (int n = 0; n < 2; ++n) acc[a][b][m][n] = (f32x4){0.f, 0.f, 0.f, 0.f};
    bf16x8 At[4][2], B0[2][2], B1[2][2];
    const int nt = K / BK;
    const char* cA = (const char*)A + (size_t)brow * lda * 2; const char* cB = (const char*)Bt + (size_t)bcol * ldb * 2;
    asm volatile("s_waitcnt vmcnt(0) lgkmcnt(0)" ::: "memory");
    __syncthreads();
    STAGE(SB(0, 0), cB, voffB); STAGE(SA(0, 0), cA, voffA);
    STAGE(SB(0, 1), cB + hstepB, voffB); STAGE(SA(0, 1), cA + hstepA, voffA);
    if (wr == 1) BAR;
    WAIT_V(4); BAR;
    STAGE(SB(1, 0), cB + kstep, voffB); STAGE(SA(1, 0), cA + kstep, voffA); STAGE(SB(1, 1), cB + hstepB + kstep, voffB);
    WAIT_V(6); BAR;
    for (int t = 0; t < nt - 2; t += 2) {
        const char* a1 = cA + (size_t)(t + 1) * kstep; const char* a2 = a1 + kstep; const char* a3 = a2 + kstep;
        const char* b2 = cB + (size_t)(t + 2) * kstep; const char* b3 = b2 + kstep;
        LDB(B0, 0, 0); SCHED; LDA(At, 0, 0); STAGE(SA(1, 1), a1 + hstepA, voffA);
        WAIT_L(8); BAR; WAIT_L(0); MMA(0, 0, At, B0); BAR; SCHED;
        LDB(B1, 0, 1); STAGE(SB(0, 0), b2, voffB);
        BAR; WAIT_L(0); MMA(0, 1, At, B1); BAR;
        LDA(At, 0, 1); STAGE(SA(0, 0), a2, voffA);
        BAR; WAIT_L(0); MMA(1, 0, At, B0); BAR; SCHED;
        STAGE(SB(0, 1), b2 + hstepB, voffB);
        WAIT_V(6); BAR; MMA(1, 1, At, B1); BAR;
        LDB(B0, 1, 0); SCHED; LDA(At, 1, 0); STAGE(SA(0, 1), a2 + hstepA, voffA);
        WAIT_L(8); BAR; WAIT_L(0); MMA(0, 0, At, B0); BAR; SCHED;
        LDB(B1, 1, 1); STAGE(SB(1, 0), b3, voffB);
        BAR; WAIT_L(0); MMA(0, 1, At, B1); BAR;
        LDA(At, 1, 1); STAGE(SA(1, 0), a3, voffA);
        BAR; WAIT_L(0); MMA(1, 0, At, B0); BAR; SCHED;
        STAGE(SB(1, 1), b3 + hstepB, voffB);
        WAIT_V(6); BAR; MMA(1, 1, At, B1); BAR;
    }
    { LDB(B0, 0, 0); LDA(At, 0, 0); STAGE(SA(1, 1), cA + (size_t)(nt - 1) * kstep + hstepA, voffA);
      BAR; WAIT_L(0); MMA(0, 0, At, B0); BAR;
      LDB(B1, 0, 1); BAR; WAIT_L(0); MMA(0, 1, At, B1); BAR;
      LDA(At, 0, 1); WAIT_V(4); BAR; WAIT_L(0); MMA(1, 0, At, B0); MMA(1, 1, At, B1); BAR; }
    { LDB(B0, 1, 0); LDA(At, 1, 0); WAIT_V(2); BAR; WAIT_L(0); MMA(0, 0, At, B0); BAR;
      LDB(B1, 1, 1); WAIT_V(0); BAR; WAIT_L(0); MMA(0, 1, At, B1); BAR;
      LDA(At, 1, 1); BAR; WAIT_L(0); MMA(1, 0, At, B0); MMA(1, 1, At, B1); BAR; }
    if (wr == 0) BAR;
#pragma unroll
    for (int ai = 0; ai < 2; ++ai)
#pragma unroll
        for (int m = 0; m < 4; ++m)
#pragma unroll
            for (int bj = 0; bj < 2; ++bj)
#pragma unroll
                for (int n = 0; n < 2; ++n)
                    epi_apply<MODE>(e, brow + ai * HALF + wr * 64 + m * 16 + fr, bcol + bj * HALF + wc * 32 + n * 16 + fq * 4, acc[ai][bj][m][n]);
#undef SA
#undef SB
#undef STAGE
#undef LDA
#undef LDB
#undef MMA
}

DEVFN bool tile_of(int i, int nM, int nN, int& pm, int& pn) {
    const int nwg = nM * nN; const long L = (long)i * gridDim.x + BIDX; if (L >= nwg) return false;
    int wgid = (int)L; { const int q = nwg / 8, r = nwg % 8, xcd = wgid % 8, off = wgid / 8; wgid = (xcd < r ? xcd * (q + 1) : r * (q + 1) + (xcd - r) * q) + off; }
    const int nig = 8 * nN, gid = wgid / nig, fm = gid * 8, gsz = (nM - fm) < 8 ? (nM - fm) : 8;
    pm = fm + ((wgid % nig) % gsz); pn = (wgid % nig) / gsz; return true;
}

template <int MODE>
DEVFN void gemm_phase(const bf16_t* A, int lda, const bf16_t* Bt, int ldb, int K, int N, const EpiArgs& e) {
    const int nM = MTOK / BM, nN = N / BM; int pm, pn;
    for (int i = 0; tile_of(i, nM, nN, pm, pn); ++i) gemm_tile<MODE>(A, lda, Bt, ldb, K, pm * BM, pn * BM, e);
}

DEVFN void tr_tile(const float* __restrict__ src, int ld, int Kv, int n0, int Nv, bf16_t* __restrict__ dst, int Kpad, int tk, int tn) {
    float* T = (float*)dyn_lds;
    const int tid = TIDX;
    __syncthreads();
    { const int nn = tid & 63, n = tn * 64 + nn;
#pragma unroll
      for (int i = 0; i < 8; ++i) { const int kk = (tid >> 6) + 8 * i, k = tk * 64 + kk;
          T[kk * 65 + nn] = (k < Kv && n < Nv) ? src[(size_t)k * ld + n0 + n] : 0.f; } }
    __syncthreads();
    { const int kk2 = 2 * (tid & 31);
#pragma unroll
      for (int i = 0; i < 4; ++i) { const int nn2 = (tid >> 5) + 16 * i;
          *(unsigned*)(dst + (size_t)(tn * 64 + nn2) * Kpad + tk * 64 + kk2) = pk2bf(T[kk2 * 65 + nn2], T[(kk2 + 1) * 65 + nn2]); } }
}

DEVFN void weight_prep(KP P, int l, int first_item, int item_stride) {
    unsigned char* ws = P->ws;
    const float* w_in = P->w_in + (size_t)l * DM * D_IN;
    for (int it = first_item; it < 4704; it += item_stride) {
        int t = it;
        if (t < 1024) { tr_tile(w_in, D_IN, DM, 0, 3872, (bf16_t*)(ws + OFF_W1T), DM, t & 15, t >> 4); continue; } t -= 1024;
        if (t < 512)  { tr_tile(w_in, D_IN, DM, 3872, 2048, (bf16_t*)(ws + OFF_WGT), DM, t & 15, t >> 4); continue; } t -= 512;
        if (t < 64)   { tr_tile(P->w_gate_up + (size_t)l * 160 * DM, DM, 160, 0, DM, (bf16_t*)(ws + OFF_WGUT), 256, t & 3, t >> 2); continue; } t -= 64;
        if (t < 16)   { tr_tile(P->w_decay_up + (size_t)l * 64 * DM, DM, 64, 0, DM, (bf16_t*)(ws + OFF_WDT), 64, 0, t); continue; } t -= 16;
        if (t < 16)   { tr_tile(P->w_aaa_up + (size_t)l * 64 * DM, DM, 64, 0, DM, (bf16_t*)(ws + OFF_WAT), 64, 0, t); continue; } t -= 16;
        if (t < 256)  { tr_tile(P->w_rwkv_up + (size_t)l * DM * DM, DM, DM, 0, DM, (bf16_t*)(ws + OFF_WRUT), DM, t & 15, t >> 4); continue; } t -= 256;
        if (t < 256)  { tr_tile(P->w_out + (size_t)l * DM * DM, DM, DM, 0, DM, (bf16_t*)(ws + OFF_WOUTT), DM, t & 15, t >> 4); continue; } t -= 256;
        if (t < 1024) { tr_tile(P->w_ff1 + (size_t)l * DM * DFF, DFF, DM, 0, DFF, (bf16_t*)(ws + OFF_WFF1T), DM, t & 15, t >> 4); continue; } t -= 1024;
        if (t < 1024) { tr_tile(P->w_ff2 + (size_t)l * DFF * DM, DM, DFF, 0, DM, (bf16_t*)(ws + OFF_WFF2T), DFF, t & 63, t >> 6); continue; } t -= 1024;
        {
            const int kk = t, g = kk >> 7;
            const float* mix = P->pool_mix + (size_t)l * 4 * 128 * 128 + (size_t)kk * 128;
            const float* sc = P->pool_scale + (size_t)l * 512 + g * 128;
            const float* wpu = P->w_pool_up + (size_t)l * 512 * DM + (size_t)g * 128 * DM;
            float a0 = 0.f, a1 = 0.f; const int n = TIDX;
            for (int d = 0; d < 128; ++d) { const float s = mix[d] * sc[d]; a0 += s * wpu[(size_t)d * DM + n]; a1 += s * wpu[(size_t)d * DM + n + 512]; }
            bf16_t* dst = (bf16_t*)(ws + OFF_WPUT);
            dst[(size_t)n * 512 + kk] = (bf16_t)(pk2bf(a0, 0.f) & 0xffffu); dst[(size_t)(n + 512) * 512 + kk] = (bf16_t)(pk2bf(a1, 0.f) & 0xffffu);
        }
    }
}

DEVFN void mod_partial(KP P, int item) {
    float* S = (float*)dyn_lds;
    const int kc = item / 48, rest = item % 48, l = rest / 12, j = (rest % 12) * 512 + TIDX;
    __syncthreads();
    for (int i = TIDX; i < 1024; i += NTHR) { const int kk = i >> 3, b = i & 7; const float cv = P->c[b * DM + kc * 128 + kk]; S[i] = cv * sigmoidf_(cv); }
    __syncthreads();
    float acc[8] = {0, 0, 0, 0, 0, 0, 0, 0};
    const float* w = P->w_ada + (size_t)l * DM * 6 * DM + (size_t)(kc * 128) * 6 * DM + j;
#pragma unroll 8
    for (int kk = 0; kk < 128; ++kk) { const float wv = w[(size_t)kk * 6 * DM]; const f32x4 s0 = *(const f32x4*)(S + kk * 8), s1 = *(const f32x4*)(S + kk * 8 + 4);
        acc[0] += wv * s0[0]; acc[1] += wv * s0[1]; acc[2] += wv * s0[2]; acc[3] += wv * s0[3]; acc[4] += wv * s1[0]; acc[5] += wv * s1[1]; acc[6] += wv * s1[2]; acc[7] += wv * s1[3]; }
    float* modp = (float*)(P->ws + OFF_MODP);
#pragma unroll
    for (int b = 0; b < 8; ++b) modp[((size_t)(kc * 4 + l) * 8 + b) * 6 * DM + j] = acc[b];
}

DEVFN void mod_reduce(KP P) {
    const float* modp = (const float*)(P->ws + OFF_MODP); float* mod = (float*)(P->ws + OFF_MOD);
    for (int idx = BIDX * NTHR + TIDX; idx < 4 * 8 * 6 * DM; idx += gridDim.x * NTHR) {
        const int j = idx % (6 * DM), l = idx / (8 * 6 * DM);
        float s = P->b_ada[l * 6 * DM + j];
#pragma unroll
        for (int kc = 0; kc < 8; ++kc) s += modp[(size_t)kc * 4 * 8 * 6 * DM + idx];
        mod[idx] = s;
    }
}

DEVFN void modulate_phase(const float* __restrict__ x, const float* __restrict__ modl, int kshift, bf16_t* __restrict__ h) {
    for (size_t i = (size_t)BIDX * NTHR + TIDX; i < (size_t)MTOK * DM / 4; i += (size_t)gridDim.x * NTHR) {
        const size_t e = i * 4; const int row = (int)(e >> 10), col = (int)(e & 1023), b = row >> 12;
        const f32x4 xv = *(const f32x4*)(x + e);
        const f32x4 sh = *(const f32x4*)(modl + (size_t)b * 6 * DM + kshift * DM + col), sc = *(const f32x4*)(modl + (size_t)b * 6 * DM + (kshift + 1) * DM + col);
        u32x2 w; w.x = pk2bf(xv[0] * (1.f + sc[0]) + sh[0], xv[1] * (1.f + sc[1]) + sh[1]); w.y = pk2bf(xv[2] * (1.f + sc[2]) + sh[2], xv[3] * (1.f + sc[3]) + sh[3]);
        *(u32x2*)(h + e) = w;
    }
}

DEVFN void ln_phase(float* __restrict__ xy, const float* __restrict__ g, const float* __restrict__ bb, const float* __restrict__ modl, int kshift, bf16_t* __restrict__ h) {
    const int wv = TIDX >> 6, lane = TIDX & 63;
    for (int row = BIDX * 8 + wv; row < MTOK; row += gridDim.x * 8) {
        float* p = xy + (size_t)row * DM;
        f32x4 v[4]; float s = 0.f;
#pragma unroll
        for (int i = 0; i < 4; ++i) { v[i] = *(const f32x4*)(p + i * 256 + lane * 4); s += (v[i][0] + v[i][1]) + (v[i][2] + v[i][3]); }
        s = wave_sum(s); const float mean = s * (1.0f / DM);
        float q = 0.f;
#pragma unroll
        for (int i = 0; i < 4; ++i) { const f32x4 d = v[i] - mean; q += (d[0] * d[0] + d[1] * d[1]) + (d[2] * d[2] + d[3] * d[3]); }
        q = wave_sum(q); const float rstd = rsqrtf(q * (1.0f / DM) + LN_EPS);
        const int b = row >> 12;
#pragma unroll
        for (int i = 0; i < 4; ++i) {
            const int col = i * 256 + lane * 4;
            const f32x4 gv = *(const f32x4*)(g + col), bv = *(const f32x4*)(bb + col);
            f32x4 o; for (int j = 0; j < 4; ++j) o[j] = (v[i][j] - mean) * rstd * gv[j] + bv[j];
            *(f32x4*)(p + col) = o;
            if (h) {
                const f32x4 sh = *(const f32x4*)(modl + (size_t)b * 6 * DM + kshift * DM + col), sc = *(const f32x4*)(modl + (size_t)b * 6 * DM + (kshift + 1) * DM + col);
                u32x2 w; w.x = pk2bf(o[0] * (1.f + sc[0]) + sh[0], o[1] * (1.f + sc[1]) + sh[1]); w.y = pk2bf(o[2] * (1.f + sc[2]) + sh[2], o[3] * (1.f + sc[3]) + sh[3]);
                *(u32x2*)(h + (size_t)row * DM + col) = w;
            }
        }
    }
}

constexpr int CH = 32;
constexpr int SC_VEC = 0;
constexpr int SC_PP = 81920;
constexpr int SC_TWXA = SC_PP + 17408;
constexpr int SC_VB = SC_TWXA + 9216;
constexpr int SC_OB = SC_VB + 8192;
constexpr int SC_SC = SC_OB + 8192;
constexpr int SC_PAR = SC_SC + 512;
constexpr int SC_WL = SC_PAR + 2560;

DEVFN void scan_unit(KP P, int l, int unit) {
    const int q = unit >> 4, half = (unit >> 3) & 1, xx = unit & 7, head = q * 8 + xx, b = head >> 4, h = head & 15;
    const int tid = TIDX, wv = __builtin_amdgcn_readfirstlane(tid >> 6), lane = tid & 63;
    float* VEC = (float*)(dyn_lds + SC_VEC);
    float* PPall = (float*)(dyn_lds + SC_PP);
    unsigned char* TWXAall = dyn_lds + SC_TWXA;
    float* VB = (float*)(dyn_lds + SC_VB);
    float* OB = (float*)(dyn_lds + SC_OB);
    float* SCB = (float*)(dyn_lds + SC_SC);
    float* PAR = (float*)(dyn_lds + SC_PAR);
    unsigned char* WL = dyn_lds + SC_WL;
    const bf16_t* p = (const bf16_t*)(P->ws + OFF_P);
    bf16_t* obuf = (bf16_t*)(P->ws + OFF_O);
    float* bonus = (float*)(P->ws + OFF_BONUS);
    __syncthreads();
    for (int i = tid; i < 640; i += NTHR) {
        const int a = i >> 6, cix = i & 63; float v;
        const float* mu = P->mu_shift + (size_t)l * D_SH;
        if (a == 0) v = mu[h * 64 + cix]; else if (a == 1) v = mu[1024 + h * 64 + cix]; else if (a == 2) v = mu[2048 + h * 64 + cix];
        else if (a == 3) v = mu[3072 + cix]; else if (a == 4) v = mu[3136 + cix];
        else if (a == 5) v = P->w0[l * DM + h * 64 + cix]; else if (a == 6) v = P->a0[l * DM + h * 64 + cix];
        else if (a == 7) v = P->k_k[l * DM + h * 64 + cix]; else if (a == 8) v = P->k_a[l * DM + h * 64 + cix]; else v = P->r_k[l * DM + h * 64 + cix];
        PAR[i] = v;
    }
#pragma unroll
    for (int i = 0; i < 2; ++i) {
        const int idx = tid + i * NTHR, mtx = idx >> 9, n = (idx >> 3) & 63, k8 = idx & 7;
        const bf16_t* wt = (const bf16_t*)(P->ws + (mtx ? OFF_WAT : OFF_WDT));
        *(u32x4*)(WL + mtx * 9216 + n * 144 + k8 * 16) = *(const u32x4*)(wt + (size_t)(h * 64 + n) * 64 + k8 * 8);
    }
    __syncthreads();

    u32x4 rc[5], rp[5];
    auto issue_loads = [&](const int cc) {
        const int pw = wv - 4, t8 = lane >> 3, c8 = (lane & 7) * 8, tseq = cc * CH + pw * 8 + t8;
        const bf16_t* pr = p + ((size_t)b * SEQ + tseq) * NP1;
        const int cols[5] = {512 + h * 64 + c8, 1536 + h * 64 + c8, 2560 + h * 64 + c8, 3584 + c8, 3648 + c8};
#pragma unroll
        for (int g = 0; g < 5; ++g) {
            rc[g] = *(const u32x4*)(pr + cols[g]);
            if (tseq > 0) rp[g] = *(const u32x4*)(pr - NP1 + cols[g]); else rp[g] = (u32x4){0u, 0u, 0u, 0u};
        }
    };
    auto prepare = [&](const int cc, const int nb) {
        const int pw = wv - 4, t8 = lane >> 3, part = lane & 7, c8 = part * 8, tloc = pw * 8 + t8;
        const int tseq = cc * CH + tloc; const size_t tok = (size_t)b * SEQ + tseq;
        unsigned char* TW = TWXAall + pw * 2304; float* PPw = PPall + pw * 1088;
        float r[8], k[8], v[8];
        {
            float xw[8], xa[8];
            {
                float cur[8], prv[8];
#define MIX(dst, g, muoff) { unpack8(rc[g], cur); unpack8(rp[g], prv); for (int j = 0; j < 8; ++j) dst[j] = cur[j] + (prv[j] - cur[j]) * PAR[(muoff) * 64 + c8 + j]; }
                MIX(r, 0, 0); MIX(k, 1, 1); MIX(v, 2, 2); MIX(xw, 3, 3); MIX(xa, 4, 4);
#undef MIX
            }
            if (cc + 1 < SEQ / CH) issue_loads(cc + 1);
            u32x4 tw, ta;
            tw.x = pk2bf(tanh_fast(xw[0]), tanh_fast(xw[1])); tw.y = pk2bf(tanh_fast(xw[2]), tanh_fast(xw[3])); tw.z = pk2bf(tanh_fast(xw[4]), tanh_fast(xw[5])); tw.w = pk2bf(tanh_fast(xw[6]), tanh_fast(xw[7]));
            ta.x = pk2bf(xa[0], xa[1]); ta.y = pk2bf(xa[2], xa[3]); ta.z = pk2bf(xa[4], xa[5]); ta.w = pk2bf(xa[6], xa[7]);
            *(u32x4*)(TW + t8 * 144 + c8 * 2) = tw;
            *(u32x4*)(TW + 1152 + t8 * 144 + c8 * 2) = ta;
        }
        asm volatile("s_waitcnt lgkmcnt(0)" ::: "memory");
        {
            const int fr = lane & 15, fq = lane >> 4;
#pragma unroll
            for (int mtx = 0; mtx < 2; ++mtx) {
                const unsigned char* ab = TW + mtx * 1152 + (fr & 7) * 144 + fq * 16;
                const bf16x8 a0 = *(const bf16x8*)(ab), a1 = *(const bf16x8*)(ab + 64);
#pragma unroll
                for (int ct = 0; ct < 4; ++ct) {
                    const unsigned char* bb = WL + mtx * 9216 + (ct * 16 + fr) * 144 + fq * 16;
                    const bf16x8 b0 = *(const bf16x8*)(bb), b1 = *(const bf16x8*)(bb + 64);
                    f32x4 acc = {0.f, 0.f, 0.f, 0.f};
                    acc = __builtin_amdgcn_mfma_f32_16x16x32_bf16(a0, b0, acc, 0, 0, 0);
                    acc = __builtin_amdgcn_mfma_f32_16x16x32_bf16(a1, b1, acc, 0, 0, 0);
                    if (fq < 2) {
#pragma unroll
                        for (int j = 0; j < 4; ++j) PPw[mtx * 544 + (fq * 4 + j) * 68 + ct * 16 + fr] = acc[j];
                    }
                }
            }
        }
        asm volatile("s_waitcnt lgkmcnt(0)" ::: "memory");
        {
            const f32x4 d0 = *(const f32x4*)(PPw + t8 * 68 + c8), d1 = *(const f32x4*)(PPw + t8 * 68 + c8 + 4);
            const f32x4 e0 = *(const f32x4*)(PPw + 544 + t8 * 68 + c8), e1 = *(const f32x4*)(PPw + 544 + t8 * 68 + c8 + 4);
            float dp[8] = {d0[0], d0[1], d0[2], d0[3], d1[0], d1[1], d1[2], d1[3]}, ap[8] = {e0[0], e0[1], e0[2], e0[3], e1[0], e1[1], e1[2], e1[3]};
            float kkr[8], ss = 0.f;
#pragma unroll
            for (int j = 0; j < 8; ++j) { kkr[j] = k[j] * PAR[7 * 64 + c8 + j]; ss += kkr[j] * kkr[j]; }
            ss = oct_sum(ss);
            const float inv = __builtin_amdgcn_rsqf(fmaxf(ss, 1e-24f));
            float va[8], vw[8], vb[8], vk[8], vwr[8], br = 0.f, kr = 0.f, bo = 0.f;
#pragma unroll
            for (int j = 0; j < 8; ++j) {
                const float wpre = PAR[5 * 64 + c8 + j] + dp[j];
                const float z = -wpre;
                const float sp = fmaxf(z, 0.f) + __logf(1.0f + __expf(-fabsf(z)));
                const float w = -sp - 0.5f;
                const float dec = __expf(-__expf(w));
                const float alr = sigmoidf_(PAR[6 * 64 + c8 + j] + ap[j]);
                const float kk = kkr[j] * inv;
                const float kn = k[j] * (1.0f + (alr - 1.0f) * PAR[8 * 64 + c8 + j]);
                va[j] = -kk; vb[j] = kk * alr; vw[j] = dec; vk[j] = kn; vwr[j] = dec * r[j];
                br += vb[j] * r[j]; kr += kn * r[j]; bo += r[j] * kn * PAR[9 * 64 + c8 + j];
            }
            br = oct_sum(br); kr = oct_sum(kr); bo = oct_sum(bo);
            float* vt = VEC + nb * 10240 + tloc * 320 + c8;
            *(f32x4*)(vt) = (f32x4){va[0], va[1], va[2], va[3]};        *(f32x4*)(vt + 4) = (f32x4){va[4], va[5], va[6], va[7]};
            *(f32x4*)(vt + 64) = (f32x4){vw[0], vw[1], vw[2], vw[3]};   *(f32x4*)(vt + 68) = (f32x4){vw[4], vw[5], vw[6], vw[7]};
            *(f32x4*)(vt + 128) = (f32x4){vb[0], vb[1], vb[2], vb[3]};  *(f32x4*)(vt + 132) = (f32x4){vb[4], vb[5], vb[6], vb[7]};
            *(f32x4*)(vt + 192) = (f32x4){vk[0], vk[1], vk[2], vk[3]};  *(f32x4*)(vt + 196) = (f32x4){vk[4], vk[5], vk[6], vk[7]};
            *(f32x4*)(vt + 256) = (f32x4){vwr[0], vwr[1], vwr[2], vwr[3]}; *(f32x4*)(vt + 260) = (f32x4){vwr[4], vwr[5], vwr[6], vwr[7]};
            if ((part >> 2) == half) { float* vbp = VB + nb * 1024 + tloc * 32 + (c8 & 31); *(f32x4*)(vbp) = (f32x4){v[0], v[1], v[2], v[3]}; *(f32x4*)(vbp + 4) = (f32x4){v[4], v[5], v[6], v[7]}; }
            if (part == 0) { SCB[nb * 64 + tloc * 2] = br; SCB[nb * 64 + tloc * 2 + 1] = kr; if (half == 0) bonus[tok * 16 + h] = bo; }
        }
    };
    auto writeout = [&](const int cc, const int ob) {
        const int i = tid - 256, t = i >> 3, part = i & 7;
        const size_t tok = (size_t)b * SEQ + cc * CH + t;
        const f32x4 ov = *(const f32x4*)(OB + ob * 1024 + t * 32 + part * 4);
        u32x2 w; w.x = pk2bf(ov[0], ov[1]); w.y = pk2bf(ov[2], ov[3]);
        *(u32x2*)(obuf + tok * DM + h * 64 + half * 32 + part * 4) = w;
    };

    if (wv >= 4) { issue_loads(0); prepare(0, 0); }
    __syncthreads();
    const int rl = lane >> 3, kseg = lane & 7, myrow = 8 * (wv & 3) + rl;
    f32x2 S2[4] = {{0.f, 0.f}, {0.f, 0.f}, {0.f, 0.f}, {0.f, 0.f}};
    for (int c = 0; c < SEQ / CH; ++c) {
        if (wv < 4) {
            __builtin_amdgcn_s_setprio(2);
            const int cb = c & 1;
            const float* V0 = VEC + cb * 10240 + 8 * kseg; const float* vbp = VB + cb * 1024 + myrow; const float* scp = SCB + cb * 64; float* obp = OB + cb * 1024 + myrow;
            f32x4 a0 = *(const f32x4*)(V0), a1 = *(const f32x4*)(V0 + 4), w0 = *(const f32x4*)(V0 + 64), w1 = *(const f32x4*)(V0 + 68),
                  b0 = *(const f32x4*)(V0 + 128), b1 = *(const f32x4*)(V0 + 132), k0 = *(const f32x4*)(V0 + 192), k1 = *(const f32x4*)(V0 + 196),
                  q0 = *(const f32x4*)(V0 + 256), q1 = *(const f32x4*)(V0 + 260);
            float vv = vbp[0]; f32x2 sc = *(const f32x2*)(scp);
#define LO2(x) __builtin_shufflevector(x, x, 0, 1)
#define HI2(x) __builtin_shufflevector(x, x, 2, 3)
#pragma unroll 2
            for (int tt = 0; tt < CH; ++tt) {
                const int tn = (tt + 1) & (CH - 1);
                const float* Vn = V0 + tn * 320;
                const f32x4 na0 = *(const f32x4*)(Vn), na1 = *(const f32x4*)(Vn + 4), nw0 = *(const f32x4*)(Vn + 64), nw1 = *(const f32x4*)(Vn + 68),
                            nb0 = *(const f32x4*)(Vn + 128), nb1 = *(const f32x4*)(Vn + 132), nk0 = *(const f32x4*)(Vn + 192), nk1 = *(const f32x4*)(Vn + 196),
                            nq0 = *(const f32x4*)(Vn + 256), nq1 = *(const f32x4*)(Vn + 260);
                const float nvv = vbp[tn * 32]; const f32x2 nsc = *(const f32x2*)(scp + tn * 2);
                f32x2 da = S2[0] * LO2(a0); da = S2[1] * HI2(a0) + da; da = S2[2] * LO2(a1) + da; da = S2[3] * HI2(a1) + da;
                f32x2 dq = S2[0] * LO2(q0); dq = S2[1] * HI2(q0) + dq; dq = S2[2] * LO2(q1) + dq; dq = S2[3] * HI2(q1) + dq;
                float sa = da[0] + da[1], op = dq[0] + dq[1];
                sa = oct_sum(sa); op = oct_sum(op);
                const f32x2 sa2 = {sa, sa}, vv2 = {vv, vv};
                { f32x2 t = vv2 * LO2(k0); t = sa2 * LO2(b0) + t; S2[0] = S2[0] * LO2(w0) + t; }
                { f32x2 t = vv2 * HI2(k0); t = sa2 * HI2(b0) + t; S2[1] = S2[1] * HI2(w0) + t; }
                { f32x2 t = vv2 * LO2(k1); t = sa2 * LO2(b1) + t; S2[2] = S2[2] * LO2(w1) + t; }
                { f32x2 t = vv2 * HI2(k1); t = sa2 * HI2(b1) + t; S2[3] = S2[3] * HI2(w1) + t; }
                const float o = op + sa * sc[0] + vv * sc[1];
                if (kseg == 0) obp[tt * 32] = o;
                a0 = na0; a1 = na1; w0 = nw0; w1 = nw1; b0 = nb0; b1 = nb1; k0 = nk0; k1 = nk1; q0 = nq0; q1 = nq1; vv = nvv; sc = nsc;
            }
#undef LO2
#undef HI2
            __builtin_amdgcn_s_setprio(0);
        } else {
            if (c + 1 < SEQ / CH) prepare(c + 1, (c + 1) & 1);
            if (c >= 1) writeout(c - 1, (c - 1) & 1);
        }
        __syncthreads();
    }
    if (wv >= 4) writeout(SEQ / CH - 1, (SEQ / CH - 1) & 1);
}

DEVFN void elem_phase(KP P, int l) {
    const bf16_t* p = (const bf16_t*)(P->ws + OFF_P);
    bf16_t* mb = (bf16_t*)(P->ws + OFF_MB); bf16_t* ga = (bf16_t*)(P->ws + OFF_GA); bf16_t* ob = (bf16_t*)(P->ws + OFF_O);
    const float* bonus = (const float*)(P->ws + OFF_BONUS);
    const float* mu = P->mu_shift + (size_t)l * D_SH;
    const int tid = TIDX;
    for (int blk = BIDX; blk < MTOK / 16; blk += gridDim.x) {
        const int tok0 = blk * 16;
#pragma unroll 1
        for (int rep = 0; rep < 2; ++rep) {
            const int idx = tid + rep * NTHR, tl = idx >> 6, cg8 = (idx & 63) * 8, tok = tok0 + tl, tseq = tok & (SEQ - 1);
            const int win = 2 << (cg8 >> 7); const int cnt = (tseq + 1) < win ? (tseq + 1) : win;
            float acc[8] = {0, 0, 0, 0, 0, 0, 0, 0}, self[8], tmp[8];
            const bf16_t* src = p + (size_t)tok * NP1 + cg8;
            unpack8(*(const u32x4*)src, self);
            for (int j = 0; j < 8; ++j) acc[j] = self[j];
            for (int s = 1; s < cnt; ++s) { unpack8(*(const u32x4*)(src - (size_t)s * NP1), tmp); for (int j = 0; j < 8; ++j) acc[j] += tmp[j]; }
            const float ic = 1.0f / (float)cnt;
            u32x4 w; w.x = pk2bf(acc[0] * ic - self[0], acc[1] * ic - self[1]); w.y = pk2bf(acc[2] * ic - self[2], acc[3] * ic - self[3]);
            w.z = pk2bf(acc[4] * ic - self[4], acc[5] * ic - self[5]); w.w = pk2bf(acc[6] * ic - self[6], acc[7] * ic - self[7]);
            *(u32x4*)(mb + (size_t)tok * 512 + cg8) = w;
        }
        {
            const int tl = tid >> 5, c8 = (tid & 31) * 8, tok = tok0 + tl, tseq = tok & (SEQ - 1);
            u32x4 w = {0u, 0u, 0u, 0u};
            if (c8 < 160) {
                float cur[8], prv[8], o[8];
                const bf16_t* src = p + (size_t)tok * NP1 + 3712 + c8;
                unpack8(*(const u32x4*)src, cur);
                if (tseq > 0) unpack8(*(const u32x4*)(src - NP1), prv); else { for (int j = 0; j < 8; ++j) prv[j] = 0.f; }
                for (int j = 0; j < 8; ++j) o[j] = sigmoidf_(cur[j] + (prv[j] - cur[j]) * mu[3200 + c8 + j]);
                w.x = pk2bf(o[0], o[1]); w.y = pk2bf(o[2], o[3]); w.z = pk2bf(o[4], o[5]); w.w = pk2bf(o[6], o[7]);
            }
            *(u32x4*)(ga + (size_t)tok * 256 + c8) = w;
        }
#pragma unroll 1
        for (int rep = 0; rep < 4; ++rep) {
            const int idx = tid + rep * NTHR, tl = idx >> 7, hh = (idx >> 3) & 15, part = idx & 7, tok = tok0 + tl, tseq = tok & (SEQ - 1);
            const int ch = hh * 64 + part * 8;
            float o[8], cur[8], prv[8];
            bf16_t* op = ob + (size_t)tok * DM + ch;
            unpack8(*(const u32x4*)op, o);
            float s = 0.f; for (int j = 0; j < 8; ++j) s += o[j];
            s = oct_sum(s); const float mean = s * (1.0f / 64.0f);
            float qv = 0.f; for (int j = 0; j < 8; ++j) { const float d = o[j] - mean; qv += d * d; }
            qv = oct_sum(qv); const float rstd = rsqrtf(qv * (1.0f / 64.0f) + GN_EPS);
            const bf16_t* src = p + (size_t)tok * NP1 + 512 + 2048 + ch;
            unpack8(*(const u32x4*)src, cur);
            if (tseq > 0) unpack8(*(const u32x4*)(src - NP1), prv); else { for (int j = 0; j < 8; ++j) prv[j] = 0.f; }
            const float bo = bonus[(size_t)tok * 16 + hh];
            float res[8];
            for (int j = 0; j < 8; ++j) {
                const float vv = cur[j] + (prv[j] - cur[j]) * mu[2048 + ch + j];
                res[j] = (o[j] - mean) * rstd * P->gn_g[l * DM + ch + j] + P->gn_b[l * DM + ch + j] + bo * vv;
            }
            u32x4 w; w.x = pk2bf(res[0], res[1]); w.y = pk2bf(res[2], res[3]); w.z = pk2bf(res[4], res[5]); w.w = pk2bf(res[6], res[7]);
            *(u32x4*)op = w;
        }
    }
}

constexpr int PH_PRE = 3, PH_PER_LAYER = 10, N_PHASES = PH_PRE + DEPTH * PH_PER_LAYER;

DEVFN void run_phase(KP P, int ph) {
    unsigned char* ws = P->ws; asm volatile("" : "+s"(ws));
    const float* mod = (const float*)(ws + OFF_MOD);
    bf16_t* hbuf = (bf16_t*)(ws + OFF_H);
    if (ph == 0) {
        for (int it = BIDX; it < 384; it += gridDim.x) mod_partial(P, it);
        int first = (int)BIDX - (384 % (int)gridDim.x); if (first < 0) first += gridDim.x;
        weight_prep(P, 0, first, gridDim.x);
        return;
    }
    if (ph == 1) { mod_reduce(P); return; }
    if (ph == 2) { modulate_phase(P->x, mod, 0, hbuf); return; }
    const int l = (ph - PH_PRE) / PH_PER_LAYER, s = (ph - PH_PRE) % PH_PER_LAYER;
    const float* modl = mod + (size_t)l * 8 * 6 * DM;
    EpiArgs e{};
    switch (s) {
    case 0: {
        e.o16 = (bf16_t*)(ws + OFF_P); e.ld = NP1;
        gemm_phase<0>(hbuf, DM, (const bf16_t*)(ws + OFF_W1T), DM, DM, NP1, e);
    } break;
    case 1: {
        for (int u = BIDX; u < 256; u += gridDim.x) scan_unit(P, l, u);
    } break;
    case 2: elem_phase(P, l); break;
    case 3: {
        e.o16 = (bf16_t*)(ws + OFF_O); e.ld = DM;
        gemm_phase<1>((const bf16_t*)(ws + OFF_GA), 256, (const bf16_t*)(ws + OFF_WGUT), 256, 256, DM, e);
    } break;
    case 4: {
        e.ld = DM; e.o16 = (bf16_t*)(ws + OFF_MIX); e.o16b = (const bf16_t*)(ws + OFF_TMP);
        EpiArgs e2{}; e2.ld = DM; e2.o16 = (bf16_t*)(ws + OFF_TMP);
        gemm_phase<2>(hbuf, DM, (const bf16_t*)(ws + OFF_WGT) + (size_t)DM * DM, DM, DM, DM, e2);
        gemm_phase<2>(hbuf, DM, (const bf16_t*)(ws + OFF_WGT), DM, DM, DM, e);
        gemm_phase<3>((const bf16_t*)(ws + OFF_MB), 512, (const bf16_t*)(ws + OFF_WPUT), 512, 512, DM, e);
        gemm_phase<4>((const bf16_t*)(ws + OFF_O), DM, (const bf16_t*)(ws + OFF_WRUT), DM, DM, DM, e);
    } break;
    case 5: {
        e.xsrc = (l == 0) ? P->x : P->out; e.y = P->out; e.gate = modl + 2 * DM;
        gemm_phase<5>((const bf16_t*)(ws + OFF_MIX), DM, (const bf16_t*)(ws + OFF_WOUTT), DM, DM, DM, e);
    } break;
    case 6: ln_phase(P->out, P->ln1_g + l * DM, P->ln1_b + l * DM, modl, 3, hbuf); break;
    case 7: {
        e.o16 = (bf16_t*)(ws + OFF_HID); e.ld = DFF;
        gemm_phase<6>(hbuf, DM, (const bf16_t*)(ws + OFF_WFF1T), DM, DM, DFF, e);
    } break;
    case 8: {
        e.xsrc = P->out; e.y = P->out; e.gate = modl + 5 * DM;
        gemm_phase<5>((const bf16_t*)(ws + OFF_HID), DFF, (const bf16_t*)(ws + OFF_WFF2T), DFF, DFF, DM, e);
    } break;
    case 9: {
        if (l + 1 < DEPTH) { ln_phase(P->out, P->ln2_g + l * DM, P->ln2_b + l * DM, modl + 8 * 6 * DM, 0, hbuf); weight_prep(P, l + 1, BIDX, gridDim.x); }
        else ln_phase(P->out, P->ln2_g + l * DM, P->ln2_b + l * DM, modl, 0, (bf16_t*)nullptr);
    } break;
    }
}

DEVFN void grid_barrier(unsigned* bar, unsigned& epoch) {
    asm volatile("s_waitcnt vmcnt(0) lgkmcnt(0)" ::: "memory");
    __syncthreads();
    epoch += 1;
    if (threadIdx.x == 0) {
        __builtin_amdgcn_fence(__ATOMIC_RELEASE, "agent");
        asm volatile("s_waitcnt vmcnt(0)" ::: "memory");
        const unsigned target = epoch * gridDim.x;
        __hip_atomic_fetch_add(bar, 1u, __ATOMIC_RELAXED, __HIP_MEMORY_SCOPE_AGENT);
        while (__hip_atomic_load(bar, __ATOMIC_RELAXED, __HIP_MEMORY_SCOPE_AGENT) < target) __builtin_amdgcn_s_sleep(2);
        __builtin_amdgcn_fence(__ATOMIC_ACQUIRE, "agent");
        asm volatile("s_waitcnt vmcnt(0)" ::: "memory");
    }
    __syncthreads();
}

__global__ void __launch_bounds__(NTHR, 2) mega_kernel(Params Parg, int ph0, int ph1) {
    cg::grid_group grid = cg::this_grid();
    unsigned epoch = 0;
    for (int ph = ph0; ph < ph1; ++ph) {
        KP P = (KP)__builtin_amdgcn_kernarg_segment_ptr(); asm volatile("" : "+s"(P));
        run_phase(P, ph);
        if (ph + 1 < ph1) {
            if (ph == ph0) grid.sync();
            else grid_barrier((unsigned*)(P->ws + OFF_BAR), epoch);
        }
    }
}

#ifndef DBG_STOP
#define DBG_STOP 0
#endif
__global__ void dbg_dump(const unsigned char* ws, size_t off, float* out) {
    const bf16_t* b = (const bf16_t*)(ws + off);
    for (size_t i = (size_t)blockIdx.x * blockDim.x + threadIdx.x; i < (size_t)MTOK * DM; i += (size_t)gridDim.x * blockDim.x)
        out[i] = __uint_as_float((unsigned)b[i] << 16);
}
extern "C" void kernel_launch(void* const* d_in, const int* in_sizes, int n_in, void* d_out, int out_size, void* d_ws, size_t ws_size,
                              hipStream_t stream) {
    static int grid_blocks = 0;
    if (!grid_blocks) {
        hipFuncSetAttribute((const void*)mega_kernel, hipFuncAttributeMaxDynamicSharedMemorySize, LDS_BYTES);
        int dev = 0, cus = 0, per_cu = 0;
        hipGetDevice(&dev);
        hipDeviceGetAttribute(&cus, hipDeviceAttributeMultiprocessorCount, dev);
        hipOccupancyMaxActiveBlocksPerMultiprocessor(&per_cu, mega_kernel, NTHR, LDS_BYTES);
        if (per_cu < 1) per_cu = 1;
        grid_blocks = cus * per_cu;
    }
    Params p{};
    const float** pp = (const float**)&p;
    for (int i = 0; i < 27; ++i) pp[i] = (const float*)d_in[i];
    p.out = (float*)d_out; p.ws = (unsigned char*)d_ws;
#if SINGLE_LAUNCH
    int ph0 = 0, ph1 = N_PHASES;
    void* args[] = {&p, &ph0, &ph1};
    hipMemsetAsync((unsigned char*)d_ws + OFF_BAR, 0, 256, stream);
    hipError_t e = hipLaunchCooperativeKernel((const void*)mega_kernel, dim3(grid_blocks), dim3(NTHR), args, LDS_BYTES, stream);
    if (e != hipSuccess) fprintf(stderr, "cooperative launch failed: %s (grid %d)\n", hipGetErrorString(e), grid_blocks);
#else
    const int nph = DBG_STOP ? DBG_STOP : N_PHASES;
    for (int ph = 0; ph < nph; ++ph) mega_kernel<<<dim3(grid_blocks), dim3(NTHR), LDS_BYTES, stream>>>(p, ph, ph + 1);
    if (DBG_STOP) dbg_dump<<<1024, 256, 0, stream>>>((const unsigned char*)d_ws, DBG_OFF, (float*)d_out);
#endif
}
```
